# Optimizing an MI355X kernel written in HIP

```python
import math
import jax, jax.numpy as jnp
from jax import lax
import numpy as np

D_MODEL = 1024
BATCH = 16
SEQ = 2048
DEPTH = 2
DEC_BATCH = 8
DEC_SEQ = 2048
PAST_LEN = 128

GRID_W = 64
D_FF = 2816
N_EVEN = (DEPTH + 1) // 2
N_ODD = DEPTH // 2
EPS = 1e-6
POOL_WIDTH = D_MODEL // 2
POOL_GROUPS = 4
POOL_GROUP_W = POOL_WIDTH // POOL_GROUPS
POOL_WINDOWS = (2, 4, 8, 16)
HYENA_WIDTH = D_MODEL // 2
HYENA_BANDS = 16
HYENA_EMB = 1 + 2 * HYENA_BANDS
HYENA_FILTER_HIDDEN = 64
HYENA_SHORT = 3
HYENA_MOD_SHIFT = 0.05
HYENA_DECAY_TARGET = 1e-2
HYENA_FAST_DECAY_PCT = 0.3
HYENA_SLOW_DECAY_PCT = 1.5
AB_IN = POOL_WIDTH + 3 * HYENA_WIDTH
AB_OUT = POOL_WIDTH + HYENA_WIDTH
N_HEADS = 16
HEAD_DIM = D_MODEL // N_HEADS
NA_MAX_ROWS = 8
NA_COLS = 16

kernel_name = "hybrid_pool_hyena_natten_encoder"


def rmsnorm(x, g):
    xf = x.astype(jnp.float32)
    y = xf * lax.rsqrt(jnp.mean(xf * xf, axis=-1, keepdims=True) + EPS)
    return (y * g.astype(jnp.float32)).astype(x.dtype)


def swiglu(x, wg, wu, wd):
    return (jax.nn.silu(x @ wg) * (x @ wu)) @ wd


def pool_mixer(u, w_grp, scale):
    B, L, _ = u.shape
    t = np.arange(L)[:, None]
    w = np.array(POOL_WINDOWS)[None, :]
    lo = np.clip(t - w // 2, 0, L - 1)
    hi = np.clip(t + w - w // 2 - 1, 0, L - 1)
    cnt = (hi - lo + 1).astype(np.float32)
    gidx = np.arange(POOL_GROUPS)[None, :]
    uf = u.astype(jnp.float32).reshape(B, L, POOL_GROUPS, POOL_GROUP_W)
    cs = jnp.concatenate([jnp.zeros((B, 1, POOL_GROUPS, POOL_GROUP_W), jnp.float32),
                          jnp.cumsum(uf, axis=1)], axis=1)
    win_sum = cs[:, hi + 1, gidx, :] - cs[:, lo, gidx, :]
    pooled = (win_sum / cnt[None, :, :, None] - uf).astype(u.dtype)
    mixed = jnp.einsum('blgc,gcd->blgd', pooled, w_grp)
    return mixed.reshape(B, L, POOL_WIDTH) * scale


def short_conv(u, w, b):
    up = jnp.pad(u, ((0, 0), (1, 1), (0, 0)))
    return up[:, :-2] * w[0] + up[:, 1:-1] * w[1] + up[:, 2:] * w[2] + b


def hyena_filter_fft(L, w1, b1, w2, b2, w3, b3, freq, w_out, deltas):
    t_idx = jnp.arange(L, dtype=jnp.float32)
    t_norm = jnp.linspace(0.0, 1.0, L, dtype=jnp.float32)
    bands = jnp.linspace(1e-4, HYENA_BANDS - 1, HYENA_BANDS, dtype=jnp.float32)
    ang = (2.0 * math.pi / L) * t_idx[:, None] * bands[None, :]
    z = jnp.concatenate([t_norm[:, None], jnp.cos(ang), -jnp.sin(ang)], axis=-1)
    h = jnp.sin(freq * (z @ w1 + b1))
    h = jnp.sin(freq * (h @ w2 + b2))
    h = jnp.sin(freq * (h @ w3 + b3))
    h = (h @ w_out).astype(jnp.float32)
    decay = jnp.exp(-t_norm[:, None] * jnp.abs(deltas.astype(jnp.float32)))
    h = (h * (decay + HYENA_MOD_SHIFT)).reshape(L, 2, HYENA_WIDTH)
    k = jnp.concatenate([h[:, 0], jnp.zeros((1, HYENA_WIDTH), jnp.float32), h[:0:-1, 1]], axis=0)
    return jnp.fft.rfft(k, axis=0)


def fftconv(u, k_f, bias):
    L = u.shape[1]
    uf = u.astype(jnp.float32)
    y = jnp.fft.irfft(jnp.fft.rfft(uf, n=2 * L, axis=1) * k_f[None], n=2 * L, axis=1)[:, :L]
    return y + uf * bias.astype(jnp.float32)


def pool_hyena_mixer(xn, w_in, pool_w, pool_scale, short_w, short_b, fw1, fb1, fw2, fb2, fw3, fb3,
                     ffreq, fw_out, fdeltas, h_bias, w_out):
    L = xn.shape[1]
    p = xn @ w_in
    a = pool_mixer(p[..., :POOL_WIDTH], pool_w, pool_scale)
    hb = short_conv(p[..., POOL_WIDTH:], short_w, short_b)
    x0 = hb[..., :HYENA_WIDTH]
    x1 = hb[..., HYENA_WIDTH:2 * HYENA_WIDTH]
    v = hb[..., 2 * HYENA_WIDTH:]
    k_f = hyena_filter_fft(L, fw1, fb1, fw2, fb2, fw3, fb3, ffreq, fw_out, fdeltas)
    yh = (fftconv(v * x1, k_f, h_bias) * x0.astype(jnp.float32)).astype(xn.dtype)
    return jnp.concatenate([a, yh], axis=-1) @ w_out


def na_mixer(xn, w_qkv, gq, gk, rpb, w_o):
    B, L, _ = xn.shape
    rows = L // GRID_W
    kh = min(NA_MAX_ROWS, rows)
    qkv = (xn @ w_qkv).reshape(B, L, 3, N_HEADS, HEAD_DIM)
    q = rmsnorm(qkv[:, :, 0], gq)
    k = rmsnorm(qkv[:, :, 1], gk)
    v = qkv[:, :, 2]

    def to_grid(a):
        return a.reshape(B, rows, GRID_W, N_HEADS, HEAD_DIM).transpose(0, 3, 1, 2, 4)

    qg, kg, vg = to_grid(q), to_grid(k), to_grid(v)
    c = np.arange(GRID_W)
    c_start = np.clip(c - NA_COLS // 2, 0, GRID_W - NA_COLS)
    col_mask = (c[None, :] >= c_start[:, None]) & (c[None, :] < c_start[:, None] + NA_COLS)
    dc_idx = np.clip(c[None, :] - c[:, None] + NA_COLS - 1, 0, 2 * NA_COLS - 2)
    rpb_cols = rpb[:, :, dc_idx].astype(jnp.float32)
    scale = HEAD_DIM ** -0.5

    def one_row(r):
        s = jnp.clip(r - kh // 2, 0, rows - kh)
        k_blk = lax.dynamic_slice_in_dim(kg, s, kh, axis=2)
        v_blk = lax.dynamic_slice_in_dim(vg, s, kh, axis=2)
        q_r = lax.dynamic_index_in_dim(qg, r, axis=2, keepdims=False)
        sc = jnp.einsum('bhqd,bhikd->bhqik', q_r, k_blk, preferred_element_type=jnp.float32) * scale
        dr = s + jnp.arange(kh) - r + NA_MAX_ROWS - 1
        bias = jnp.take(rpb_cols, dr, axis=1).transpose(0, 2, 1, 3)
        sc = jnp.where(col_mask[:, None, :], sc + bias, -jnp.inf)
        p = jax.nn.softmax(sc, axis=(-2, -1))
        return jnp.einsum('bhqik,bhikd->bhqd', p.astype(v_blk.dtype), v_blk)

    out = lax.map(one_row, jnp.arange(rows))
    out = out.transpose(1, 0, 3, 2, 4).reshape(B, L, D_MODEL)
    return out @ w_o


def run_trunk(x, norm_g, ffn_w_gate, ffn_w_up, ffn_w_down, w_in_ab, pool_w, pool_scale, short_w, short_b,
              filt_w1, filt_b1, filt_w2, filt_b2, filt_w3, filt_b3, filt_freq, filt_w_out, filt_deltas,
              hyena_bias, w_out_ab, w_qkv, q_norm_g, k_norm_g, rpb, w_o):
    for layer in range(DEPTH):
        x = x + 0.5 * swiglu(rmsnorm(x, norm_g[layer, 0]), ffn_w_gate[layer, 0], ffn_w_up[layer, 0], ffn_w_down[layer, 0])
        xn = rmsnorm(x, norm_g[layer, 1])
        i = layer // 2
        if layer % 2 == 0:
            mix = pool_hyena_mixer(xn, w_in_ab[i], pool_w[i], pool_scale[i], short_w[i], short_b[i],
                                   filt_w1[i], filt_b1[i], filt_w2[i], filt_b2[i], filt_w3[i], filt_b3[i],
                                   filt_freq[i], filt_w_out[i], filt_deltas[i], hyena_bias[i], w_out_ab[i])
        else:
            mix = na_mixer(xn, w_qkv[i], q_norm_g[i], k_norm_g[i], rpb[i], w_o[i])
        x = x + mix
        x = x + 0.5 * swiglu(rmsnorm(x, norm_g[layer, 2]), ffn_w_gate[layer, 1], ffn_w_up[layer, 1], ffn_w_down[layer, 1])
    return x


def setup_inputs(seed: int = 0) -> dict:
    key = jax.random.key(seed)
    ks = jax.random.split(key, 32)

    def nrm(k, shape, s):
        return jax.random.normal(k, shape, jnp.float32) * s

    max_decay = math.log(HYENA_DECAY_TARGET) / HYENA_FAST_DECAY_PCT
    min_decay = math.log(HYENA_DECAY_TARGET) / HYENA_SLOW_DECAY_PCT
    base_deltas = jnp.tile(jnp.linspace(min_decay, max_decay, HYENA_WIDTH, dtype=jnp.float32), 2)
    return {
        "x_prompt": nrm(ks[0], (BATCH, SEQ, D_MODEL), 1.0),
        "x_sample": nrm(ks[1], (DEC_BATCH, DEC_SEQ, D_MODEL), 1.0),
        "norm_g": 1.0 + nrm(ks[2], (DEPTH, 3, D_MODEL), 0.02),
        "ffn_w_gate": nrm(ks[3], (DEPTH, 2, D_MODEL, D_FF), D_MODEL ** -0.5),
        "ffn_w_up": nrm(ks[4], (DEPTH, 2, D_MODEL, D_FF), D_MODEL ** -0.5),
        "ffn_w_down": nrm(ks[5], (DEPTH, 2, D_FF, D_MODEL), D_FF ** -0.5),
        "w_in_ab": nrm(ks[6], (N_EVEN, D_MODEL, AB_IN), D_MODEL ** -0.5),
        "pool_w": nrm(ks[7], (N_EVEN, POOL_GROUPS, POOL_GROUP_W, POOL_GROUP_W), POOL_GROUP_W ** -0.5),
        "pool_scale": 1.0 + nrm(ks[8], (N_EVEN, POOL_WIDTH), 0.02),
        "short_w": nrm(ks[9], (N_EVEN, HYENA_SHORT, 3 * HYENA_WIDTH), HYENA_SHORT ** -0.5),
        "short_b": nrm(ks[10], (N_EVEN, 3 * HYENA_WIDTH), 0.01),
        "filt_w1": nrm(ks[11], (N_EVEN, HYENA_EMB, HYENA_FILTER_HIDDEN), HYENA_EMB ** -0.5),
        "filt_b1": nrm(ks[12], (N_EVEN, HYENA_FILTER_HIDDEN), 0.1),
        "filt_w2": nrm(ks[13], (N_EVEN, HYENA_FILTER_HIDDEN, HYENA_FILTER_HIDDEN), HYENA_FILTER_HIDDEN ** -0.5),
        "filt_b2": nrm(ks[14], (N_EVEN, HYENA_FILTER_HIDDEN), 0.1),
        "filt_w3": nrm(ks[15], (N_EVEN, HYENA_FILTER_HIDDEN, HYENA_FILTER_HIDDEN), HYENA_FILTER_HIDDEN ** -0.5),
        "filt_b3": nrm(ks[16], (N_EVEN, HYENA_FILTER_HIDDEN), 0.1),
        "filt_freq": 1.0 + nrm(ks[17], (N_EVEN, HYENA_FILTER_HIDDEN), 0.1),
        "filt_w_out": nrm(ks[18], (N_EVEN, HYENA_FILTER_HIDDEN, 2 * HYENA_WIDTH), 0.05 * HYENA_FILTER_HIDDEN ** -0.5),
        "filt_deltas": base_deltas[None, :] + nrm(ks[19], (N_EVEN, 2 * HYENA_WIDTH), 0.1),
        "hyena_bias": nrm(ks[20], (N_EVEN, HYENA_WIDTH), 0.1),
        "w_out_ab": nrm(ks[21], (N_EVEN, AB_OUT, D_MODEL), AB_OUT ** -0.5),
        "w_qkv": nrm(ks[22], (N_ODD, D_MODEL, 3 * D_MODEL), D_MODEL ** -0.5),
        "q_norm_g": 1.0 + nrm(ks[23], (N_ODD, HEAD_DIM), 0.02),
        "k_norm_g": 1.0 + nrm(ks[24], (N_ODD, HEAD_DIM), 0.02),
        "rpb": nrm(ks[25], (N_ODD, N_HEADS, 2 * NA_MAX_ROWS - 1, 2 * NA_COLS - 1), 0.1),
        "w_o": nrm(ks[26], (N_ODD, D_MODEL, D_MODEL), D_MODEL ** -0.5),
    }


def reference(x_prompt, x_sample, norm_g, ffn_w_gate, ffn_w_up, ffn_w_down, w_in_ab, pool_w, pool_scale,
              short_w, short_b, filt_w1, filt_b1, filt_w2, filt_b2, filt_w3, filt_b3, filt_freq, filt_w_out,
              filt_deltas, hyena_bias, w_out_ab, w_qkv, q_norm_g, k_norm_g, rpb, w_o):
    y_prompt = run_trunk(x_prompt, norm_g, ffn_w_gate, ffn_w_up, ffn_w_down, w_in_ab, pool_w, pool_scale,
                         short_w, short_b, filt_w1, filt_b1, filt_w2, filt_b2, filt_w3, filt_b3, filt_freq,
                         filt_w_out, filt_deltas, hyena_bias, w_out_ab, w_qkv, q_norm_g, k_norm_g, rpb, w_o)
    y_sample = run_trunk(x_sample, norm_g, ffn_w_gate, ffn_w_up, ffn_w_down, w_in_ab, pool_w, pool_scale,
                         short_w, short_b, filt_w1, filt_b1, filt_w2, filt_b2, filt_w3, filt_b3, filt_freq,
                         filt_w_out, filt_deltas, hyena_bias, w_out_ab, w_qkv, q_norm_g, k_norm_g, rpb, w_o)
    return (y_prompt, y_sample)
```

```cpp
#include <hip/hip_runtime.h>
#include <hip/hip_cooperative_groups.h>
#include <cstdio>
namespace cg = cooperative_groups;
namespace pg8 {
#define PG8_LAS __attribute__((address_space(3)))
typedef unsigned short bf16_t;
typedef short bf16x8 __attribute__((ext_vector_type(8)));
typedef float f32x4 __attribute__((ext_vector_type(4)));
typedef unsigned u32x4 __attribute__((ext_vector_type(4)));
constexpr int BM = 256, BK = 64, HALF = 128, HTB = HALF * BK * 2  , STAGE_BYTES = 8 * HTB, NXCD = 8, WGM = 8;

__host__ __device__ __forceinline__ int lds_byte(int r, int c) { const int st = (r >> 4) * 2 + (c >> 5), rr = r & 15, cc = c & 31, ob = rr * 64 + cc * 2; return st * 1024 + (ob ^ (((ob >> 9) & 1) << 5)); }
__host__ __device__ __forceinline__ void stage_rc(int b, int& R, int& C) { const int st = b / 1024, sb = b % 1024, swz = sb ^ (((sb >> 9) & 1) << 5); R = (st >> 1) * 16 + swz / 64; C = (st & 1) * 32 + (swz % 64) / 2; }
__host__ __device__ __forceinline__ int perm32(int rho) { const int n = rho >> 4, i = rho & 15; return 8 * (i >> 2) + 4 * n + (i & 3); }

struct Unit { int pm, pn; };
struct Gemm { const bf16_t* A; const bf16_t* Bt; int M, N, K; };

struct StaticOrder {
    int nM, nN, nwg, G, c;
    __host__ __device__ void init(int M, int N, int G_, int c_) { nM = M / BM; nN = N / BM; nwg = nM * nN; G = G_; c = c_; }
    __host__ __device__ bool next(int i, Unit& u) const {
        const long L = (long)i * G + c; if (L >= nwg) return false;
        int wgid = (int)L; { const int q = nwg / NXCD, r = nwg % NXCD, xcd = wgid % NXCD, off = wgid / NXCD; wgid = (xcd < r ? xcd * (q + 1) : r * (q + 1) + (xcd - r) * q) + off; }
        const int nig = WGM * nN, gid = wgid / nig, fm = gid * WGM, gsz = (nM - fm) < WGM ? (nM - fm) : WGM;
        u.pm = fm + ((wgid % nig) % gsz); u.pn = (wgid % nig) / gsz; return true;
    }
    __device__ __forceinline__ void a_ready(const Unit&) const {}
    __device__ __forceinline__ void done(const Unit&) const {}
};
__device__ __forceinline__ unsigned cvt_pk_bf16(float lo, float hi) { unsigned r; asm volatile("v_cvt_pk_bf16_f32 %0, %1, %2" : "=v"(r) : "v"(lo), "v"(hi)); return r; }
typedef float f32x2 __attribute__((ext_vector_type(2)));
__device__ __forceinline__ float silu_f(float g) { return g * __builtin_amdgcn_rcpf(1.0f + __expf(-g)); }
__device__ __forceinline__ float bflo(unsigned w) { return __uint_as_float(w << 16); }
__device__ __forceinline__ float bfhi(unsigned w) { return __uint_as_float(w & 0xffff0000u); }

struct EpiGU {
    static constexpr bool PERM = true, AFTER_DRAIN = false;
    bf16_t* H; int ldh; const float* ss;
    __device__ __forceinline__ void operator()(const f32x4 (&acc)[2][2][4][2], const Unit& u, int wr, int wc, int fr, int fq) const {
        const int row0 = u.pm * BM + wr * 64 + fr, col0 = u.pn * HALF + wc * 32 + 8 * fq;
#pragma unroll
        for (int ai = 0; ai < 2; ++ai)
#pragma unroll
            for (int m = 0; m < 4; ++m) {
                const int row = row0 + ai * HALF + m * 16;
                const float rstd = rsqrtf(ss[row] * (1.0f / 1024.0f) + 1e-6f);
                float hv[8];
#pragma unroll
                for (int n = 0; n < 2; ++n)
#pragma unroll
                    for (int j = 0; j < 4; ++j) hv[n * 4 + j] = silu_f(acc[ai][0][m][n][j] * rstd) * (acc[ai][1][m][n][j] * rstd);
                u32x4 w; w.x = cvt_pk_bf16(hv[0], hv[1]); w.y = cvt_pk_bf16(hv[2], hv[3]); w.z = cvt_pk_bf16(hv[4], hv[5]); w.w = cvt_pk_bf16(hv[6], hv[7]);
                *(u32x4*)(H + (size_t)row * ldh + col0) = w;
            }
    }
};
struct EpiScale {
    static constexpr bool PERM = true, AFTER_DRAIN = false;
    bf16_t* O; int ldc; const float* ss;
    __device__ __forceinline__ void operator()(const f32x4 (&acc)[2][2][4][2], const Unit& u, int wr, int wc, int fr, int fq) const {
        const int row0 = u.pm * BM + wr * 64 + fr, col0 = u.pn * BM + wc * 32 + 8 * fq;
#pragma unroll
        for (int ai = 0; ai < 2; ++ai)
#pragma unroll
            for (int m = 0; m < 4; ++m) {
                const int row = row0 + ai * HALF + m * 16;
                const float rstd = rsqrtf(ss[row] * (1.0f / 1024.0f) + 1e-6f);
#pragma unroll
                for (int bj = 0; bj < 2; ++bj) {
                    const f32x4 v0 = acc[ai][bj][m][0] * rstd, v1 = acc[ai][bj][m][1] * rstd;
                    u32x4 w; w.x = cvt_pk_bf16(v0[0], v0[1]); w.y = cvt_pk_bf16(v0[2], v0[3]); w.z = cvt_pk_bf16(v1[0], v1[1]); w.w = cvt_pk_bf16(v1[2], v1[3]);
                    *(u32x4*)(O + (size_t)row * ldc + col0 + bj * HALF) = w;
                }
            }
    }
};
struct EpiRes {
    static constexpr bool PERM = true, AFTER_DRAIN = false;
    bf16_t* X; float* outf; float alpha; float* ssn;
    __device__ __forceinline__ void operator()(const f32x4 (&acc)[2][2][4][2], const Unit& u, int wr, int wc, int fr, int fq) const {
        const int row0 = u.pm * BM + wr * 64 + fr, col0 = u.pn * BM + wc * 32 + 8 * fq;
#pragma unroll
        for (int ai = 0; ai < 2; ++ai)
#pragma unroll
            for (int m = 0; m < 4; ++m) {
                const int row = row0 + ai * HALF + m * 16;
                float sq = 0.f;
#pragma unroll
                for (int bj = 0; bj < 2; ++bj) {
                    bf16_t* xp = X + (size_t)row * 1024 + col0 + bj * HALF;
                    const u32x4 xo = *(const u32x4*)xp;
                    float v[8];
                    v[0] = bflo(xo.x) + alpha * acc[ai][bj][m][0][0]; v[1] = bfhi(xo.x) + alpha * acc[ai][bj][m][0][1];
                    v[2] = bflo(xo.y) + alpha * acc[ai][bj][m][0][2]; v[3] = bfhi(xo.y) + alpha * acc[ai][bj][m][0][3];
                    v[4] = bflo(xo.z) + alpha * acc[ai][bj][m][1][0]; v[5] = bfhi(xo.z) + alpha * acc[ai][bj][m][1][1];
                    v[6] = bflo(xo.w) + alpha * acc[ai][bj][m][1][2]; v[7] = bfhi(xo.w) + alpha * acc[ai][bj][m][1][3];
                    if (outf) {
                        float* op = outf + (size_t)row * 1024 + col0 + bj * HALF;
                        *(f32x4*)op = (f32x4){v[0], v[1], v[2], v[3]}; *(f32x4*)(op + 4) = (f32x4){v[4], v[5], v[6], v[7]};
                    } else {
                        u32x4 w; w.x = cvt_pk_bf16(v[0], v[1]); w.y = cvt_pk_bf16(v[2], v[3]); w.z = cvt_pk_bf16(v[4], v[5]); w.w = cvt_pk_bf16(v[6], v[7]);
                        *(u32x4*)xp = w;
                        sq += bflo(w.x) * bflo(w.x) + bfhi(w.x) * bfhi(w.x) + bflo(w.y) * bflo(w.y) + bfhi(w.y) * bfhi(w.y)
                            + bflo(w.z) * bflo(w.z) + bfhi(w.z) * bfhi(w.z) + bflo(w.w) * bflo(w.w) + bfhi(w.w) * bfhi(w.w);
                    }
                }
                if (ssn) {
                    sq += __shfl_xor(sq, 16); sq += __shfl_xor(sq, 32);
                    if (fq == 0) atomicAdd(ssn + row, sq);
                }
            }
    }
};
template <class Epi, class Sched, bool STAMP = false>
__device__ __forceinline__ void gemm_phase(PG8_LAS unsigned char* lds, const Gemm g, const Sched& S, const Epi& E, unsigned long long* stamps, const int tid) {
    const int wid = __builtin_amdgcn_readfirstlane(tid >> 6), lane = tid & 63, wr = wid >> 2, wc = wid & 3, fr = lane & 15, fq = lane >> 4;
    const int K = g.K, nt = K / BK;
    int ts_lo = 0, ts_hi = 0, nts = 0; const unsigned long long rt_entry = STAMP ? (unsigned long long)wall_clock64() : 0ull;
#define PG8_STAMP() do { if (STAMP && wid == 0 && nts < 64) { const unsigned long long _c = (unsigned long long)clock64(); \
        ts_lo = (lane == nts) ? (int)(unsigned)_c : ts_lo; ts_hi = (lane == nts) ? (int)(unsigned)(_c >> 32) : ts_hi; ++nts; } } while (0)
    PG8_STAMP();
    unsigned voffA[2], voffB[2];
#pragma unroll
    for (int i = 0; i < 2; ++i) { int R, C; stage_rc(tid * 16 + i * 8192, R, C); const int Rb = Epi::PERM ? ((R & ~31) + perm32(R & 31)) : R;
        voffA[i] = (unsigned)(R * K + C) * 2u; voffB[i] = (unsigned)(Rb * K + C) * 2u; }
    const size_t kstep = (size_t)(BK * 2);
    const size_t hstep = (size_t)HALF * K * 2;
    const size_t tstep = 2 * hstep;
    const unsigned ldsw = (unsigned)wid * 1024u;
    const int aoff = lds_byte(wr * 64 + fr, fq * 8), boff = lds_byte(wc * 32 + fr, fq * 8);
#define PG8_SA(b, h) (((b) * 2 + (h)) * HTB)
#define PG8_SB(b, h) ((4 + (b) * 2 + (h)) * HTB)
#define PG8_STAGE(bufoff, gbase, voff) do { _Pragma("unroll") for (int _i = 0; _i < 2; ++_i) \
        __builtin_amdgcn_global_load_lds((const unsigned*)((const char*)(gbase) + (voff)[_i]), (PG8_LAS unsigned*)(lds + (bufoff) + ldsw + _i * 8192), 16, 0, 0); } while (0)
#define PG8_LDA(dst, b, h) do { _Pragma("unroll") for (int m = 0; m < 4; ++m) _Pragma("unroll") for (int k = 0; k < 2; ++k) dst[m][k] = *(const PG8_LAS bf16x8*)(lds + PG8_SA(b, h) + aoff + m * 2048 + k * 1024); } while (0)
#define PG8_LDB(dst, b, h) do { _Pragma("unroll") for (int n = 0; n < 2; ++n) _Pragma("unroll") for (int k = 0; k < 2; ++k) dst[n][k] = *(const PG8_LAS bf16x8*)(lds + PG8_SB(b, h) + boff + n * 2048 + k * 1024); } while (0)
#define PG8_MMA(ai, bj, At, Bt) do { __builtin_amdgcn_s_setprio(1); _Pragma("unroll") for (int m = 0; m < 4; ++m) _Pragma("unroll") for (int n = 0; n < 2; ++n) _Pragma("unroll") for (int k = 0; k < 2; ++k) \
        acc[ai][bj][m][n] = __builtin_amdgcn_mfma_f32_16x16x32_bf16(Bt[n][k], At[m][k], acc[ai][bj][m][n], 0, 0, 0); __builtin_amdgcn_s_setprio(0); } while (0)
#define PG8_WAIT_V(n) asm volatile("s_waitcnt vmcnt(" #n ")" ::: "memory")
#define PG8_WAIT_L(n) asm volatile("s_waitcnt lgkmcnt(" #n ")" ::: "memory")
#define PG8_BAR __builtin_amdgcn_s_barrier()
#define PG8_SCHED __builtin_amdgcn_sched_barrier(0)
    Unit cur, nxt; int ui = 0;
    if (!S.next(0, cur)) return;
    f32x4 acc[2][2][4][2];
#pragma unroll
    for (int a = 0; a < 2; ++a)
#pragma unroll
        for (int b = 0; b < 2; ++b)
#pragma unroll
            for (int m = 0; m < 4; ++m)
#pragma unroll
                for (int n = 0; n < 2; ++n) acc[a][b][m][n] = (f32x4){0.f, 0.f, 0.f, 0.f};
    bf16x8 At[4][2], B0[2][2], B1[2][2];
    const char* cA = (const char*)g.A + (size_t)cur.pm * tstep; const char* cB = (const char*)g.Bt + (size_t)cur.pn * tstep;
    S.a_ready(cur);
    PG8_STAGE(PG8_SB(0, 0), cB, voffB); PG8_STAGE(PG8_SA(0, 0), cA, voffA); PG8_STAGE(PG8_SB(0, 1), cB + hstep, voffB); PG8_STAGE(PG8_SA(0, 1), cA + hstep, voffA);
    if (wr == 1) PG8_BAR;
    PG8_WAIT_V(4); PG8_BAR;
    PG8_STAGE(PG8_SB(1, 0), cB + kstep, voffB); PG8_STAGE(PG8_SA(1, 0), cA + kstep, voffA); PG8_STAGE(PG8_SB(1, 1), cB + hstep + kstep, voffB);
    PG8_WAIT_V(6); PG8_BAR;
    PG8_STAMP();
    for (;;) {
        const bool has_next = S.next(ui + 1, nxt);
        const char* nA = has_next ? (const char*)g.A + (size_t)nxt.pm * tstep : cA; const char* nB = has_next ? (const char*)g.Bt + (size_t)nxt.pn * tstep : cB;
        for (int t = 0; t < nt; t += 2) {
            const bool last = (t == nt - 2);
            const char* a1 = cA + (size_t)(t + 1) * kstep;
            const char* a2 = last ? nA : cA + (size_t)(t + 2) * kstep; const char* b2 = last ? nB : cB + (size_t)(t + 2) * kstep;
            const char* a3 = a2 + kstep; const char* b3 = b2 + kstep;
            if (last && has_next) S.a_ready(nxt);
            PG8_LDB(B0, 0, 0); PG8_SCHED; PG8_LDA(At, 0, 0); PG8_STAGE(PG8_SA(1, 1), a1 + hstep, voffA);
            PG8_WAIT_L(8); PG8_BAR; PG8_WAIT_L(0); PG8_MMA(0, 0, At, B0); PG8_BAR; PG8_SCHED;
            PG8_LDB(B1, 0, 1); PG8_STAGE(PG8_SB(0, 0), b2, voffB);
            PG8_BAR; PG8_WAIT_L(0); PG8_MMA(0, 1, At, B1); PG8_BAR;
            PG8_LDA(At, 0, 1); PG8_STAGE(PG8_SA(0, 0), a2, voffA);
            PG8_BAR; PG8_WAIT_L(0); PG8_MMA(1, 0, At, B0); PG8_BAR; PG8_SCHED;
            PG8_STAGE(PG8_SB(0, 1), b2 + hstep, voffB);
            PG8_WAIT_V(6); PG8_BAR; PG8_MMA(1, 1, At, B1); PG8_BAR;
            PG8_LDB(B0, 1, 0); PG8_SCHED; PG8_LDA(At, 1, 0); PG8_STAGE(PG8_SA(0, 1), a2 + hstep, voffA);
            PG8_WAIT_L(8); PG8_BAR; PG8_WAIT_L(0); PG8_MMA(0, 0, At, B0); PG8_BAR; PG8_SCHED;
            PG8_LDB(B1, 1, 1); PG8_STAGE(PG8_SB(1, 0), b3, voffB);
            PG8_BAR; PG8_WAIT_L(0); PG8_MMA(0, 1, At, B1); PG8_BAR;
            PG8_LDA(At, 1, 1); PG8_STAGE(PG8_SA(1, 0), a3, voffA);
            PG8_BAR; PG8_WAIT_L(0); PG8_MMA(1, 0, At, B0); PG8_BAR; PG8_SCHED;
            PG8_STAGE(PG8_SB(1, 1), b3 + hstep, voffB);
            PG8_WAIT_V(6); PG8_BAR; PG8_MMA(1, 1, At, B1); PG8_BAR;
        }
        PG8_STAMP();
        if constexpr (!Epi::AFTER_DRAIN) { E(acc, cur, wr, wc, fr, fq); S.done(cur); }
        PG8_STAMP();
        if (!has_next) break;
#pragma unroll
        for (int a = 0; a < 2; ++a)
#pragma unroll
            for (int b = 0; b < 2; ++b)
#pragma unroll
                for (int m = 0; m < 4; ++m)
#pragma unroll
                    for (int n = 0; n < 2; ++n) acc[a][b][m][n] = (f32x4){0.f, 0.f, 0.f, 0.f};
        cur = nxt; cA = nA; cB = nB; ++ui;
    }
    PG8_WAIT_V(0);
    if (wr == 0) PG8_BAR;
    PG8_BAR;
    if constexpr (Epi::AFTER_DRAIN) { E.fused(acc, cur, wr, wc, fr, fq, lds, wid, lane); S.done(cur); }
    PG8_STAMP();
    if (STAMP && wid == 0) { stamps[lane] = lane < nts ? (((unsigned long long)(unsigned)ts_hi << 32) | (unsigned)ts_lo) : 0ull;
        if (lane == 62) stamps[62] = rt_entry; if (lane == 63) stamps[63] = (unsigned long long)wall_clock64(); }
#undef PG8_STAMP
#undef PG8_SA
#undef PG8_SB
#undef PG8_STAGE
#undef PG8_LDA
#undef PG8_LDB
#undef PG8_MMA
#undef PG8_WAIT_V
#undef PG8_WAIT_L
#undef PG8_BAR
#undef PG8_SCHED
}
}

using pg8::bf16_t; using pg8::f32x4; using pg8::u32x4; using pg8::cvt_pk_bf16; using pg8::bflo; using pg8::bfhi;
typedef unsigned u32x2 __attribute__((ext_vector_type(2)));
#define LAS __attribute__((address_space(3)))
constexpr int T = 49152, D = 1024, FF = 2816, NBATCH = 24, SEQ = 2048, NPROMPT = 32768;
constexpr int NWAVES = 8, NTHREADS = 512;
constexpr int LDS_BYTES = 147456;
constexpr size_t MiB = 1u << 20;
constexpr size_t WS_SS = 0;
constexpr size_t WS_HN = 2 * MiB;
constexpr size_t WS_FT = 10 * MiB;
constexpr size_t WS_WGU = 14 * MiB;
constexpr size_t WS_WD = 58 * MiB;
constexpr size_t WS_WIN = 80 * MiB;
constexpr size_t WS_WMO = 84 * MiB;
constexpr size_t WS_WQKV = 86 * MiB;
constexpr size_t WS_WO = 92 * MiB;
constexpr size_t WS_XB = 96 * MiB;
constexpr size_t WS_BIG = 192 * MiB;
constexpr size_t WS_END = 480 * MiB;
constexpr size_t BIG_Z = 192 * MiB, BIG_YT = 240 * MiB;
constexpr size_t OUT_MID = 0, OUT_X0 = 96 * MiB;

__device__ __forceinline__ float wave_sum(float v) {
#pragma unroll
    for (int o = 1; o < 64; o <<= 1) v += __shfl_xor(v, o);
    return v;
}
__device__ __forceinline__ float wave_max(float v) {
#pragma unroll
    for (int o = 1; o < 64; o <<= 1) v = fmaxf(v, __shfl_xor(v, o));
    return v;
}
__device__ __forceinline__ unsigned f2bf(float f) { unsigned u = __float_as_uint(f); return (u + 0x7fffu + ((u >> 16) & 1u)) >> 16; }
__device__ __forceinline__ float bf2f(bf16_t b) { return __uint_as_float((unsigned)b << 16); }
#define LDS_WAIT() asm volatile("s_waitcnt lgkmcnt(0)" ::: "memory")

struct Args { const float* in[27]; float* out; unsigned char* ws; int ph_lo, ph_hi; };
typedef const Args __attribute__((address_space(4)))* CArgsP;

__device__ __forceinline__ void transpose_item(const float* W, int N, const float* ks, bf16_t* WT, int ldd, int koff, int gu, int rowadd, LAS float* scr, int item, int lane) {
    const int nblk = N / 32, kb = item / nblk, nb = item % nblk, k0 = 64 * kb, n0 = 32 * nb;
#pragma unroll 8
    for (int i = 0; i < 32; ++i) { const int kk = 2 * i + (lane >> 5); const float sc = ks ? ks[k0 + kk] : 1.0f; scr[kk * 33 + (lane & 31)] = W[(size_t)(k0 + kk) * N + n0 + (lane & 31)] * sc; }
    LDS_WAIT();
    const int c = lane & 7;
#pragma unroll
    for (int j = 0; j < 4; ++j) { const int n = (lane >> 3) + 8 * j; const LAS float* s = scr + (8 * c) * 33 + n;
        u32x4 o; o.x = cvt_pk_bf16(s[0 * 33], s[1 * 33]); o.y = cvt_pk_bf16(s[2 * 33], s[3 * 33]); o.z = cvt_pk_bf16(s[4 * 33], s[5 * 33]); o.w = cvt_pk_bf16(s[6 * 33], s[7 * 33]);
        const int nn = n0 + n; const int row = gu ? (256 * (nn >> 7) + (nn & 127) + rowadd) : (nn + rowadd);
        *(u32x4*)(WT + (size_t)row * ldd + koff + k0 + 8 * c) = o; }
    LDS_WAIT();
}
__device__ __forceinline__ void conv_matrix(const float* W, int K, int N, const float* ks, bf16_t* WT, int ldd, int koff, int gu, int rowadd, LAS float* scr, int gw, int NGW, int lane, int& off) {
    const int nitems = (K / 64) * (N / 32);
    int it0 = (gw - off) % NGW; if (it0 < 0) it0 += NGW;
    for (int it = it0; it < nitems; it += NGW) transpose_item(W, N, ks, WT, ldd, koff, gu, rowadd, scr, it, lane);
    off = (off + nitems) % NGW;
}

__device__ __forceinline__ void p0_prologue(CArgsP a, LAS unsigned char* lds, int tid, int lane, int wave, int G) {
    unsigned char* ws = a->ws;
    const int gw = blockIdx.x * NWAVES + wave, NGW = G * NWAVES;
    const int gtid = blockIdx.x * NTHREADS + tid, GT = G * NTHREADS;
    float* SS = (float*)(ws + WS_SS);
    for (int i = gtid; i < 5 * T; i += GT) SS[T + i] = 0.f;
    {
        bf16_t* XB = (bf16_t*)(ws + WS_XB);
        for (int m = gw; m < T; m += NGW) {
            const float* xr = (m < NPROMPT) ? a->in[0] + (size_t)m * D : a->in[1] + (size_t)(m - NPROMPT) * D;
            f32x4 v[4]; float s = 0.f;
#pragma unroll
            for (int j = 0; j < 4; ++j) { v[j] = ((const f32x4*)xr)[64 * j + lane]; s += (v[j].x * v[j].x + v[j].y * v[j].y) + (v[j].z * v[j].z + v[j].w * v[j].w); }
            s = wave_sum(s);
#pragma unroll
            for (int j = 0; j < 4; ++j) { u32x2 o; o.x = cvt_pk_bf16(v[j].x, v[j].y); o.y = cvt_pk_bf16(v[j].z, v[j].w); ((u32x2*)(XB + (size_t)m * D))[64 * j + lane] = o; }
            if (lane == 0) SS[m] = s;
        }
    }
    {
        LAS float* scr = (LAS float*)(lds + wave * 16384);
        int off = 0;
        const float* ng = a->in[2];
        for (int f = 0; f < 4; ++f) {
            const int layer = f >> 1, j = f & 1;
            const float* gain = ng + (size_t)(layer * 3 + (j ? 2 : 0)) * D;
            bf16_t* wgu = (bf16_t*)(ws + WS_WGU) + (size_t)f * 5632 * 1024;
            bf16_t* wd = (bf16_t*)(ws + WS_WD) + (size_t)f * 1024 * 2816;
            conv_matrix(a->in[3] + (size_t)f * D * FF, D, FF, gain, wgu, D, 0, 1, 0, scr, gw, NGW, lane, off);
            conv_matrix(a->in[4] + (size_t)f * D * FF, D, FF, gain, wgu, D, 0, 1, 128, scr, gw, NGW, lane, off);
            conv_matrix(a->in[5] + (size_t)f * FF * D, FF, D, nullptr, wd, FF, 0, 0, 0, scr, gw, NGW, lane, off);
        }
        conv_matrix(a->in[6], D, 2048, ng + 1 * D, (bf16_t*)(ws + WS_WIN), D, 0, 0, 0, scr, gw, NGW, lane, off);
        conv_matrix(a->in[22], D, 3072, ng + 4 * D, (bf16_t*)(ws + WS_WQKV), D, 0, 0, 0, scr, gw, NGW, lane, off);
        conv_matrix(a->in[26], D, D, nullptr, (bf16_t*)(ws + WS_WO), D, 0, 0, 0, scr, gw, NGW, lane, off);
        conv_matrix(a->in[21] + (size_t)512 * D, 512, D, nullptr, (bf16_t*)(ws + WS_WMO), D, 512, 0, 0, scr, gw, NGW, lane, off);
    }
    {
        const float* pw = a->in[7]; const float* psc = a->in[8]; const float* wout = a->in[21];
        bf16_t* wmo = (bf16_t*)(ws + WS_WMO);
        for (int idx = gtid; idx < 1024 * 512; idx += GT) {
            const int k = idx & 511, n = idx >> 9, g = k >> 7;
            const float* pr = pw + (size_t)k * 128;
            float s = 0.f;
            for (int d = 0; d < 128; ++d) s += pr[d] * psc[g * 128 + d] * wout[(size_t)(g * 128 + d) * D + n];
            wmo[(size_t)n * D + k] = (bf16_t)f2bf(s);
        }
    }
    {
        const float *w1 = a->in[11], *b1 = a->in[12], *w2 = a->in[13], *b2 = a->in[14], *w3 = a->in[15], *b3 = a->in[16], *freq = a->in[17], *wo = a->in[18], *deltas = a->in[19];
        float* HN = (float*)(ws + WS_HN); bf16_t* FT = (bf16_t*)(ws + WS_FT);
        for (int t = gw; t < SEQ; t += NGW) {
            const float tn = (float)t / 2047.0f;
            float zval = 0.f;
            if (lane == 0) zval = tn;
            else if (lane <= 32) {
                const int bi = (lane - 1) & 15;
                const float band = 1e-4f + (float)bi * ((15.0f - 1e-4f) / 15.0f);
                const float ang = (6.283185307179586f / 2048.0f) * (float)t * band;
                zval = (lane <= 16) ? cosf(ang) : -sinf(ang);
            }
            const float fr = freq[lane];
            float pre = b1[lane];
            for (int i = 0; i < 33; ++i) pre += __shfl(zval, i) * w1[i * 64 + lane];
            float h = sinf(fr * pre);
            pre = b2[lane];
            for (int i = 0; i < 64; ++i) pre += __shfl(h, i) * w2[i * 64 + lane];
            h = sinf(fr * pre);
            pre = b3[lane];
            for (int i = 0; i < 64; ++i) pre += __shfl(h, i) * w3[i * 64 + lane];
            h = sinf(fr * pre);
            float o[16];
#pragma unroll
            for (int q = 0; q < 16; ++q) o[q] = 0.f;
            for (int i = 0; i < 64; ++i) { const float hv = __shfl(h, i);
#pragma unroll
                for (int q = 0; q < 16; ++q) o[q] += hv * wo[i * 1024 + lane + 64 * q]; }
#pragma unroll
            for (int q = 0; q < 16; ++q) {
                const int c2 = lane + 64 * q;
                const float val = o[q] * (__expf(-tn * fabsf(deltas[c2])) + 0.05f);
                HN[(size_t)t * 1024 + c2] = val;
                const int dir = c2 >> 9, c = c2 & 511;
                if (dir == 0) FT[(size_t)c * 4096 + 2048 - t] = (bf16_t)f2bf(val);
                else FT[(size_t)c * 4096 + (t ? 2048 + t : 0)] = (bf16_t)(t ? f2bf(val) : 0u);
            }
        }
    }
}

__device__ __forceinline__ void elt0_phase(CArgsP a, int tid, int G) {
    const int gtid = blockIdx.x * NTHREADS + tid, GT = G * NTHREADS;
    const bf16_t* P = (const bf16_t*)(a->ws + WS_BIG);
    bf16_t* MIDp = (bf16_t*)((unsigned char*)a->out + OUT_MID);
    bf16_t* X0 = (bf16_t*)((unsigned char*)a->out + OUT_X0);
    bf16_t* Z = (bf16_t*)(a->ws + WS_BIG + BIG_Z);
    const float* sw = a->in[9]; const float* sb = a->in[10];
    for (int idx = gtid; idx < T * 64; idx += GT) {
        const int c8 = idx & 63, t = idx >> 6, l = t & (SEQ - 1), c = c8 * 8;
        {
            const int g = c8 >> 4, w = 2 << g;
            int lo = l - (w >> 1); if (lo < 0) lo = 0;
            int hi = l + (w >> 1) - 1; if (hi > SEQ - 1) hi = SEQ - 1;
            float s[8];
#pragma unroll
            for (int j = 0; j < 8; ++j) s[j] = 0.f;
            const bf16_t* base = P + (size_t)(t - l) * 2048 + c;
            for (int q = lo; q <= hi; ++q) {
                const u32x4 v = *(const u32x4*)(base + (size_t)q * 2048);
                s[0] += bflo(v.x); s[1] += bfhi(v.x); s[2] += bflo(v.y); s[3] += bfhi(v.y); s[4] += bflo(v.z); s[5] += bfhi(v.z); s[6] += bflo(v.w); s[7] += bfhi(v.w);
            }
            const float inv = 1.0f / (float)(hi - lo + 1);
            const u32x4 uu = *(const u32x4*)(base + (size_t)l * 2048);
            u32x4 o;
            o.x = cvt_pk_bf16(s[0] * inv - bflo(uu.x), s[1] * inv - bfhi(uu.x)); o.y = cvt_pk_bf16(s[2] * inv - bflo(uu.y), s[3] * inv - bfhi(uu.y));
            o.z = cvt_pk_bf16(s[4] * inv - bflo(uu.z), s[5] * inv - bfhi(uu.z)); o.w = cvt_pk_bf16(s[6] * inv - bflo(uu.w), s[7] * inv - bfhi(uu.w));
            *(u32x4*)(MIDp + (size_t)t * 1024 + c) = o;
        }
        {
            float r[3][8];
#pragma unroll
            for (int sg = 0; sg < 3; ++sg) {
                const int cc = sg * 512 + c;
                const bf16_t* pc = P + (size_t)t * 2048 + 512 + cc;
                const u32x4 zero = (u32x4){0u, 0u, 0u, 0u};
                const u32x4 vm = (l > 0) ? *(const u32x4*)(pc - 2048) : zero;
                const u32x4 v0 = *(const u32x4*)pc;
                const u32x4 vp = (l < SEQ - 1) ? *(const u32x4*)(pc + 2048) : zero;
                const f32x4 wa0 = *(const f32x4*)(sw + cc), wa1 = *(const f32x4*)(sw + cc + 4);
                const f32x4 wb0 = *(const f32x4*)(sw + 1536 + cc), wb1 = *(const f32x4*)(sw + 1536 + cc + 4);
                const f32x4 wc0 = *(const f32x4*)(sw + 3072 + cc), wc1 = *(const f32x4*)(sw + 3072 + cc + 4);
                const f32x4 bb0 = *(const f32x4*)(sb + cc), bb1 = *(const f32x4*)(sb + cc + 4);
                r[sg][0] = bflo(vm.x) * wa0[0] + bflo(v0.x) * wb0[0] + bflo(vp.x) * wc0[0] + bb0[0];
                r[sg][1] = bfhi(vm.x) * wa0[1] + bfhi(v0.x) * wb0[1] + bfhi(vp.x) * wc0[1] + bb0[1];
                r[sg][2] = bflo(vm.y) * wa0[2] + bflo(v0.y) * wb0[2] + bflo(vp.y) * wc0[2] + bb0[2];
                r[sg][3] = bfhi(vm.y) * wa0[3] + bfhi(v0.y) * wb0[3] + bfhi(vp.y) * wc0[3] + bb0[3];
                r[sg][4] = bflo(vm.z) * wa1[0] + bflo(v0.z) * wb1[0] + bflo(vp.z) * wc1[0] + bb1[0];
                r[sg][5] = bfhi(vm.z) * wa1[1] + bfhi(v0.z) * wb1[1] + bfhi(vp.z) * wc1[1] + bb1[1];
                r[sg][6] = bflo(vm.w) * wa1[2] + bflo(v0.w) * wb1[2] + bflo(vp.w) * wc1[2] + bb1[2];
                r[sg][7] = bfhi(vm.w) * wa1[3] + bfhi(v0.w) * wb1[3] + bfhi(vp.w) * wc1[3] + bb1[3];
            }
            u32x4 ox, oz;
            ox.x = cvt_pk_bf16(r[0][0], r[0][1]); ox.y = cvt_pk_bf16(r[0][2], r[0][3]); ox.z = cvt_pk_bf16(r[0][4], r[0][5]); ox.w = cvt_pk_bf16(r[0][6], r[0][7]);
            oz.x = cvt_pk_bf16(r[2][0] * r[1][0], r[2][1] * r[1][1]); oz.y = cvt_pk_bf16(r[2][2] * r[1][2], r[2][3] * r[1][3]);
            oz.z = cvt_pk_bf16(r[2][4] * r[1][4], r[2][5] * r[1][5]); oz.w = cvt_pk_bf16(r[2][6] * r[1][6], r[2][7] * r[1][7]);
            *(u32x4*)(X0 + (size_t)t * 512 + c) = ox;
            *(u32x4*)(Z + (size_t)t * 512 + c) = oz;
        }
    }
}

__device__ __forceinline__ void conv_naive_phase(CArgsP a, int tid, int G) {
    const int gtid = blockIdx.x * NTHREADS + tid, GT = G * NTHREADS;
    const float* HN = (const float*)(a->ws + WS_HN);
    const bf16_t* Z = (const bf16_t*)(a->ws + WS_BIG + BIG_Z);
    const bf16_t* X0 = (const bf16_t*)((unsigned char*)a->out + OUT_X0);
    bf16_t* MIDp = (bf16_t*)((unsigned char*)a->out + OUT_MID);
    const float* hb = a->in[20];
    for (int idx = gtid; idx < NBATCH * 128 * 512; idx += GT) {
        const int c = idx & 511, tc = (idx >> 9) & 127, b = idx >> 16, t0 = tc * 16;
        float acc[16];
#pragma unroll
        for (int i = 0; i < 16; ++i) acc[i] = 0.f;
        const bf16_t* zb = Z + (size_t)b * SEQ * 512 + c;
        for (int s = 0; s < SEQ; ++s) {
            const float zv = bf2f(zb[(size_t)s * 512]);
#pragma unroll
            for (int i = 0; i < 16; ++i) {
                const int lag = t0 + i - s;
                const float kv = (lag >= 0) ? HN[(size_t)lag * 1024 + c] : HN[(size_t)(-lag) * 1024 + 512 + c];
                acc[i] += kv * zv;
            }
        }
        const float bias = hb[c];
#pragma unroll
        for (int i = 0; i < 16; ++i) {
            const size_t t = (size_t)b * SEQ + t0 + i;
            const float zv = bf2f(Z[t * 512 + c]);
            const float y = (acc[i] + zv * bias) * bf2f(X0[t * 512 + c]);
            MIDp[t * 1024 + 512 + c] = (bf16_t)f2bf(y);
        }
    }
}

__device__ __forceinline__ void attn_naive_phase(CArgsP a, int lane, int wave, int G) {
    const int gw = blockIdx.x * NWAVES + wave, NGW = G * NWAVES;
    const bf16_t* QKV = (const bf16_t*)(a->ws + WS_BIG);
    bf16_t* MIDp = (bf16_t*)((unsigned char*)a->out + OUT_MID);
    const float* gq = a->in[23]; const float* gk = a->in[24]; const float* rpb = a->in[25];
    for (int item = gw; item < T * 16; item += NGW) {
        const int h = item & 15, t = item >> 4, b = t >> 11, l = t & (SEQ - 1), r = l >> 6, cq = l & 63;
        int s0 = r - 4; s0 = s0 < 0 ? 0 : (s0 > 24 ? 24 : s0);
        int cs = cq - 8; cs = cs < 0 ? 0 : (cs > 48 ? 48 : cs);
        const float gg = gq[lane] * gk[lane];
        float qg[64];
        {
            const u32x4* qp = (const u32x4*)(QKV + (size_t)t * 3072 + h * 64);
            float ss = 0.f;
#pragma unroll
            for (int j = 0; j < 8; ++j) { const u32x4 v = qp[j];
                qg[8 * j + 0] = bflo(v.x); qg[8 * j + 1] = bfhi(v.x); qg[8 * j + 2] = bflo(v.y); qg[8 * j + 3] = bfhi(v.y);
                qg[8 * j + 4] = bflo(v.z); qg[8 * j + 5] = bfhi(v.z); qg[8 * j + 6] = bflo(v.w); qg[8 * j + 7] = bfhi(v.w); }
#pragma unroll
            for (int d = 0; d < 64; ++d) ss += qg[d] * qg[d];
            const float rq = rsqrtf(ss * (1.0f / 64.0f) + 1e-6f) * 0.125f;
#pragma unroll
            for (int d = 0; d < 64; ++d) qg[d] *= rq * __shfl(gg, d);
        }
        float sc0 = 0.f, sc1 = 0.f;
#pragma unroll 1
        for (int e = 0; e < 2; ++e) {
            const int kk = lane + 64 * e, i = kk >> 4, kc = cs + (kk & 15);
            const size_t tk = (size_t)b * SEQ + (size_t)(s0 + i) * 64 + kc;
            const u32x4* kp = (const u32x4*)(QKV + tk * 3072 + 1024 + h * 64);
            float ss = 0.f, dot = 0.f;
#pragma unroll
            for (int j = 0; j < 8; ++j) { const u32x4 v = kp[j];
                const float k0 = bflo(v.x), k1 = bfhi(v.x), k2 = bflo(v.y), k3 = bfhi(v.y), k4 = bflo(v.z), k5 = bfhi(v.z), k6 = bflo(v.w), k7 = bfhi(v.w);
                ss += k0 * k0 + k1 * k1 + k2 * k2 + k3 * k3 + k4 * k4 + k5 * k5 + k6 * k6 + k7 * k7;
                dot += k0 * qg[8 * j] + k1 * qg[8 * j + 1] + k2 * qg[8 * j + 2] + k3 * qg[8 * j + 3] + k4 * qg[8 * j + 4] + k5 * qg[8 * j + 5] + k6 * qg[8 * j + 6] + k7 * qg[8 * j + 7]; }
            const float rk = rsqrtf(ss * (1.0f / 64.0f) + 1e-6f);
            const int dr = s0 + i - r + 7, dc = kc - cq + 15;
            const float scv = dot * rk + rpb[(h * 15 + dr) * 31 + dc];
            if (e == 0) sc0 = scv; else sc1 = scv;
        }
        const float mx = wave_max(fmaxf(sc0, sc1));
        const float e0 = __expf(sc0 - mx), e1 = __expf(sc1 - mx);
        const float inv = 1.0f / wave_sum(e0 + e1);
        const float p0 = e0 * inv, p1 = e1 * inv;
        float o = 0.f;
        const bf16_t* vbase = QKV + 2048 + h * 64 + lane;
#pragma unroll 4
        for (int kk = 0; kk < 64; ++kk) {
            const float pa = __shfl(p0, kk), pb = __shfl(p1, kk);
            const int i = kk >> 4, kc = cs + (kk & 15);
            const size_t tka = (size_t)b * SEQ + (size_t)(s0 + i) * 64 + kc, tkb = tka + 4 * 64;
            o += pa * bf2f(vbase[tka * 3072]) + pb * bf2f(vbase[tkb * 3072]);
        }
        MIDp[(size_t)t * 1024 + h * 64 + lane] = (bf16_t)f2bf(o);
    }
}

enum PhaseOp { OP_PREP, OP_GU, OP_DN, OP_WIN, OP_ELT0, OP_CONV, OP_MIXOUT, OP_QKV, OP_ATTN, OP_WO };
constexpr int NPHASES = 16;
__device__ __forceinline__ void phase_info(int ph, int& op, int& f) {
    f = 0;
    switch (ph) {
        case 0: op = OP_PREP; break;
        case 1: op = OP_GU; f = 0; break;  case 2: op = OP_DN; f = 0; break;
        case 3: op = OP_WIN; break;        case 4: op = OP_ELT0; break;      case 5: op = OP_CONV; break;   case 6: op = OP_MIXOUT; break;
        case 7: op = OP_GU; f = 1; break;  case 8: op = OP_DN; f = 1; break;
        case 9: op = OP_GU; f = 2; break;  case 10: op = OP_DN; f = 2; break;
        case 11: op = OP_QKV; break;       case 12: op = OP_ATTN; break;     case 13: op = OP_WO; break;
        case 14: op = OP_GU; f = 3; break; default: op = OP_DN; f = 3; break;
    }
}

__global__ void __launch_bounds__(NTHREADS, 2) mega_fwd(Args args) {
    extern __shared__ __attribute__((aligned(16))) unsigned char lds_raw[];
    LAS unsigned char* lds = (LAS unsigned char*)lds_raw;
    cg::grid_group grid = cg::this_grid();
    const int G = gridDim.x;
    for (int ph = args.ph_lo; ph < args.ph_hi; ++ph) {
        int tid = threadIdx.x; asm volatile("" : "+v"(tid));
        const int lane = tid & 63, wave = __builtin_amdgcn_readfirstlane(tid >> 6);
        CArgsP ap = (CArgsP)__builtin_amdgcn_kernarg_segment_ptr(); asm volatile("" : "+s"(ap));
        unsigned char* ws = ap->ws;
        unsigned char* outb = (unsigned char*)ap->out;
        float* SS = (float*)(ws + WS_SS);
        bf16_t* XB = (bf16_t*)(ws + WS_XB);
        bf16_t* BIG = (bf16_t*)(ws + WS_BIG);
        bf16_t* MIDp = (bf16_t*)(outb + OUT_MID);
        int op, f; phase_info(ph, op, f);
        if (op == OP_PREP) {
            p0_prologue(ap, lds, tid, lane, wave, G);
        } else if (op == OP_GU) {
            const int ssi = (f == 0) ? 0 : (f == 1) ? 2 : (f == 2) ? 3 : 5;
            pg8::Gemm g{XB, (const bf16_t*)(ws + WS_WGU) + (size_t)f * 5632 * 1024, T, 5632, D};
            pg8::StaticOrder S; S.init(T, 5632, G, (int)blockIdx.x);
            pg8::EpiGU E{BIG, FF, SS + (size_t)ssi * T};
            pg8::gemm_phase<pg8::EpiGU, pg8::StaticOrder>(lds, g, S, E, nullptr, tid);
        } else if (op == OP_DN || op == OP_MIXOUT || op == OP_WO) {
            pg8::Gemm g; float alpha; float* ssn; float* outf = nullptr;
            if (op == OP_DN) { g = pg8::Gemm{BIG, (const bf16_t*)(ws + WS_WD) + (size_t)f * 1024 * 2816, T, D, FF}; alpha = 0.5f;
                ssn = (f == 0) ? SS + 1 * (size_t)T : (f == 1) ? SS + 3 * (size_t)T : (f == 2) ? SS + 4 * (size_t)T : nullptr; if (f == 3) outf = (float*)outb; }
            else if (op == OP_MIXOUT) { g = pg8::Gemm{MIDp, (const bf16_t*)(ws + WS_WMO), T, D, D}; alpha = 1.0f; ssn = SS + 2 * (size_t)T; }
            else { g = pg8::Gemm{MIDp, (const bf16_t*)(ws + WS_WO), T, D, D}; alpha = 1.0f; ssn = SS + 5 * (size_t)T; }
            pg8::StaticOrder S; S.init(T, D, G, (int)blockIdx.x);
            pg8::EpiRes E{XB, outf, alpha, ssn};
            pg8::gemm_phase<pg8::EpiRes, pg8::StaticOrder>(lds, g, S, E, nullptr, tid);
        } else if (op == OP_WIN || op == OP_QKV) {
            const int N = (op == OP_WIN) ? 2048 : 3072;
            pg8::Gemm g{XB, (const bf16_t*)(ws + (op == OP_WIN ? WS_WIN : WS_WQKV)), T, N, D};
            pg8::StaticOrder S; S.init(T, N, G, (int)blockIdx.x);
            pg8::EpiScale E{BIG, N, SS + (size_t)(op == OP_WIN ? 1 : 4) * T};
            pg8::gemm_phase<pg8::EpiScale, pg8::StaticOrder>(lds, g, S, E, nullptr, tid);
        } else if (op == OP_ELT0) {
            elt0_phase(ap, tid, G);
        } else if (op == OP_CONV) {
            conv_naive_phase(ap, tid, G);
        } else if (op == OP_ATTN) {
            attn_naive_phase(ap, lane, wave, G);
        }
        if (ph + 1 < args.ph_hi) { __syncthreads(); grid.sync(); }
    }
}

#ifndef MK_ONE_LAUNCH
#define MK_ONE_LAUNCH 0
#endif
extern "C" void kernel_launch(void* const* d_in, const int* in_sizes, int n_in, void* d_out, int out_size, void* d_ws, size_t ws_size, hipStream_t stream) {
    static int grid = 0;
    if (grid == 0) {
        if (n_in != 27 || out_size != T * D || ws_size < WS_END) { fprintf(stderr, "kernel_launch: unexpected shapes: n_in %d out %d ws %zu\n", n_in, out_size, ws_size); grid = -1; return; }
        int dev = 0, cus = 0, per_cu = 0;
        (void)hipGetDevice(&dev); (void)hipDeviceGetAttribute(&cus, hipDeviceAttributeMultiprocessorCount, dev);
        if (hipFuncSetAttribute((const void*)mega_fwd, hipFuncAttributeMaxDynamicSharedMemorySize, LDS_BYTES) != hipSuccess) { fprintf(stderr, "kernel_launch: hipFuncSetAttribute failed\n"); grid = -1; return; }
        if (hipOccupancyMaxActiveBlocksPerMultiprocessor(&per_cu, (const void*)mega_fwd, NTHREADS, LDS_BYTES) != hipSuccess || per_cu < 1) { fprintf(stderr, "kernel_launch: occupancy query says %d\n", per_cu); per_cu = 1; }
        (void)hipGetLastError();
        grid = cus * per_cu;
        fprintf(stderr, "kernel_launch: grid %d (cus %d x %d)\n", grid, cus, per_cu);
    }
    if (grid < 0) return;
    Args a{};
    for (int i = 0; i < 27; ++i) a.in[i] = (const float*)d_in[i];
    a.out = (float*)d_out; a.ws = (unsigned char*)d_ws;
#if MK_ONE_LAUNCH
    a.ph_lo = 0; a.ph_hi = NPHASES;
    void* kargs[] = {&a};
    hipError_t e = hipLaunchCooperativeKernel((const void*)mega_fwd, dim3(grid), dim3(NTHREADS), kargs, LDS_BYTES, stream);
    if (e != hipSuccess) fprintf(stderr, "kernel_launch: cooperative launch failed: %s (grid %d)\n", hipGetErrorString(e), grid);
#else
    for (int ph = 0; ph < NPHASES; ++ph) {
        a.ph_lo = ph; a.ph_hi = ph + 1;
        hipLaunchKernelGGL(mega_fwd, dim3(grid), dim3(NTHREADS), LDS_BYTES, stream, a);
    }
#endif
}
```

```cpp
#include <hip/hip_runtime.h>
#include <hip/hip_cooperative_groups.h>
#include <cstdio>
namespace cg = cooperative_groups;
namespace pg8 {
#define PG8_LAS __attribute__((address_space(3)))
typedef unsigned short bf16_t;
typedef short bf16x8 __attribute__((ext_vector_type(8)));
typedef float f32x4 __attribute__((ext_vector_type(4)));
typedef unsigned u32x4 __attribute__((ext_vector_type(4)));
constexpr int BM = 256, BK = 64, HALF = 128, HTB = HALF * BK * 2  , STAGE_BYTES = 8 * HTB, NXCD = 8, WGM = 4;

__host__ __device__ __forceinline__ int lds_byte(int r, int c) { const int st = (r >> 4) * 2 + (c >> 5), rr = r & 15, cc = c & 31, ob = rr * 64 + cc * 2; return st * 1024 + (ob ^ (((ob >> 9) & 1) << 5)); }
__host__ __device__ __forceinline__ void stage_rc(int b, int& R, int& C) { const int st = b / 1024, sb = b % 1024, swz = sb ^ (((sb >> 9) & 1) << 5); R = (st >> 1) * 16 + swz / 64; C = (st & 1) * 32 + (swz % 64) / 2; }
__host__ __device__ __forceinline__ int perm32(int rho) { const int n = rho >> 4, i = rho & 15; return 8 * (i >> 2) + 4 * n + (i & 3); }

struct Unit { int pm, pn; };
struct Gemm { const bf16_t* A; const bf16_t* Bt; int M, N, K, lda; };

struct StaticOrder {
    int nM, nN, nwg, G, c;
    __host__ __device__ void init(int M, int N, int G_, int c_) { nM = M / BM; nN = N / BM; nwg = nM * nN; G = G_; c = c_; }
    __host__ __device__ bool next(int i, Unit& u) const {
        const long L = (long)i * G + c; if (L >= nwg) return false;
        int wgid = (int)L; { const int q = nwg / NXCD, r = nwg % NXCD, xcd = wgid % NXCD, off = wgid / NXCD; wgid = (xcd < r ? xcd * (q + 1) : r * (q + 1) + (xcd - r) * q) + off; }
        const int nig = WGM * nN, gid = wgid / nig, fm = gid * WGM, gsz = (nM - fm) < WGM ? (nM - fm) : WGM;
        u.pm = fm + ((wgid % nig) % gsz); u.pn = (wgid % nig) / gsz; return true;
    }
    __device__ __forceinline__ void a_ready(const Unit&) const {}
    __device__ __forceinline__ void done(const Unit&) const {}
};
__device__ __forceinline__ unsigned cvt_pk_bf16(float lo, float hi) { unsigned r; asm volatile("v_cvt_pk_bf16_f32 %0, %1, %2" : "=v"(r) : "v"(lo), "v"(hi)); return r; }
typedef float f32x2 __attribute__((ext_vector_type(2)));
__device__ __forceinline__ float silu_f(float g) { return g * __builtin_amdgcn_rcpf(1.0f + __expf(-g)); }
__device__ __forceinline__ float bflo(unsigned w) { return __uint_as_float(w << 16); }
__device__ __forceinline__ float bfhi(unsigned w) { return __uint_as_float(w & 0xffff0000u); }

struct EpiGU {
    static constexpr bool PERM = true, AFTER_DRAIN = false, SS_LDS = true;
    bf16_t* H; int ldh; const float* ss;
    __device__ __forceinline__ void operator()(const f32x4 (&acc)[2][2][4][2], const Unit& u, int wr, int wc, int fr, int fq, const volatile PG8_LAS float* ssl) const {
        const int row0 = u.pm * BM + wr * 64 + fr, col0 = u.pn * HALF + wc * 32 + 8 * fq;
        float ssv[2][4];
#pragma unroll
        for (int ai = 0; ai < 2; ++ai)
#pragma unroll
            for (int m = 0; m < 4; ++m) ssv[ai][m] = ssl[ai * HALF + wr * 64 + m * 16 + fr];
#pragma unroll
        for (int ai = 0; ai < 2; ++ai)
#pragma unroll
            for (int m = 0; m < 4; ++m) {
                const int row = row0 + ai * HALF + m * 16;
                const float rstd = rsqrtf(ssv[ai][m] * (1.0f / 1024.0f) + 1e-6f);
                const float r2 = rstd * rstd, nr = rstd * -1.4426950408889634f;
                unsigned wv[4];
#pragma unroll
                for (int n = 0; n < 2; ++n)
#pragma unroll
                    for (int jp = 0; jp < 2; ++jp) {
                        const f32x2 g = (f32x2){acc[ai][0][m][n][2 * jp], acc[ai][0][m][n][2 * jp + 1]}, uu = (f32x2){acc[ai][1][m][n][2 * jp], acc[ai][1][m][n][2 * jp + 1]};
                        const f32x2 t = g * nr;
                        f32x2 e; e.x = __builtin_amdgcn_exp2f(t.x); e.y = __builtin_amdgcn_exp2f(t.y);
                        const f32x2 d = e + 1.0f;
                        f32x2 rc; rc.x = __builtin_amdgcn_rcpf(d.x); rc.y = __builtin_amdgcn_rcpf(d.y);
                        const f32x2 hv = (g * uu) * (rc * r2);
                        wv[n * 2 + jp] = cvt_pk_bf16(hv.x, hv.y);
                    }
                u32x4 w; w.x = wv[0]; w.y = wv[1]; w.z = wv[2]; w.w = wv[3];
                *(u32x4*)(H + (size_t)row * ldh + col0) = w;
            }
    }
};
struct EpiScale {
    static constexpr bool PERM = true, AFTER_DRAIN = false, SS_LDS = true;
    bf16_t* O; int ldc; const float* ss;
    __device__ __forceinline__ void operator()(const f32x4 (&acc)[2][2][4][2], const Unit& u, int wr, int wc, int fr, int fq, const volatile PG8_LAS float* ssl) const {
        const int row0 = u.pm * BM + wr * 64 + fr, col0 = u.pn * BM + wc * 32 + 8 * fq;
        float ssv[2][4];
#pragma unroll
        for (int ai = 0; ai < 2; ++ai)
#pragma unroll
            for (int m = 0; m < 4; ++m) ssv[ai][m] = ssl[ai * HALF + wr * 64 + m * 16 + fr];
#pragma unroll
        for (int ai = 0; ai < 2; ++ai)
#pragma unroll
            for (int m = 0; m < 4; ++m) {
                const int row = row0 + ai * HALF + m * 16;
                const float rstd = rsqrtf(ssv[ai][m] * (1.0f / 1024.0f) + 1e-6f);
#pragma unroll
                for (int bj = 0; bj < 2; ++bj) {
                    const f32x4 v0 = acc[ai][bj][m][0] * rstd, v1 = acc[ai][bj][m][1] * rstd;
                    u32x4 w; w.x = cvt_pk_bf16(v0[0], v0[1]); w.y = cvt_pk_bf16(v0[2], v0[3]); w.z = cvt_pk_bf16(v1[0], v1[1]); w.w = cvt_pk_bf16(v1[2], v1[3]);
                    *(u32x4*)(O + (size_t)row * ldc + col0 + bj * HALF) = w;
                }
            }
    }
};
struct EpiRes {
    static constexpr bool PERM = true, AFTER_DRAIN = false, SS_LDS = false;
    bf16_t* X; float* outf; float alpha; float* ssn;
    __device__ __forceinline__ void operator()(const f32x4 (&acc)[2][2][4][2], const Unit& u, int wr, int wc, int fr, int fq, const volatile PG8_LAS float*) const {
        const int row0 = u.pm * BM + wr * 64 + fr, col0 = u.pn * BM + wc * 32 + 8 * fq;
#pragma unroll
        for (int ai = 0; ai < 2; ++ai) {
          u32x4 xold[4][2];
#pragma unroll
          for (int m = 0; m < 4; ++m)
#pragma unroll
            for (int bj = 0; bj < 2; ++bj) xold[m][bj] = *(const u32x4*)(X + (size_t)(row0 + ai * HALF + m * 16) * 1024 + col0 + bj * HALF);
#pragma unroll
            for (int m = 0; m < 4; ++m) {
                const int row = row0 + ai * HALF + m * 16;
                float sq = 0.f;
#pragma unroll
                for (int bj = 0; bj < 2; ++bj) {
                    bf16_t* xp = X + (size_t)row * 1024 + col0 + bj * HALF;
                    const u32x4 xo = xold[m][bj];
                    float v[8];
                    v[0] = bflo(xo.x) + alpha * acc[ai][bj][m][0][0]; v[1] = bfhi(xo.x) + alpha * acc[ai][bj][m][0][1];
                    v[2] = bflo(xo.y) + alpha * acc[ai][bj][m][0][2]; v[3] = bfhi(xo.y) + alpha * acc[ai][bj][m][0][3];
                    v[4] = bflo(xo.z) + alpha * acc[ai][bj][m][1][0]; v[5] = bfhi(xo.z) + alpha * acc[ai][bj][m][1][1];
                    v[6] = bflo(xo.w) + alpha * acc[ai][bj][m][1][2]; v[7] = bfhi(xo.w) + alpha * acc[ai][bj][m][1][3];
                    if (outf) {
                        float* op = outf + (size_t)row * 1024 + col0 + bj * HALF;
                        *(f32x4*)op = (f32x4){v[0], v[1], v[2], v[3]}; *(f32x4*)(op + 4) = (f32x4){v[4], v[5], v[6], v[7]};
                    } else {
                        u32x4 w; w.x = cvt_pk_bf16(v[0], v[1]); w.y = cvt_pk_bf16(v[2], v[3]); w.z = cvt_pk_bf16(v[4], v[5]); w.w = cvt_pk_bf16(v[6], v[7]);
                        *(u32x4*)xp = w;
                        sq += bflo(w.x) * bflo(w.x) + bfhi(w.x) * bfhi(w.x) + bflo(w.y) * bflo(w.y) + bfhi(w.y) * bfhi(w.y)
                            + bflo(w.z) * bflo(w.z) + bfhi(w.z) * bfhi(w.z) + bflo(w.w) * bflo(w.w) + bfhi(w.w) * bfhi(w.w);
                    }
                }
                if (ssn) {
                    sq += __shfl_xor(sq, 16); sq += __shfl_xor(sq, 32);
                    if (fq == 0) atomicAdd(ssn + row, sq);
                }
            }
        }
    }
};
template <class Epi, class Sched, bool STAMP = false>
__device__ __forceinline__ void gemm_phase(PG8_LAS unsigned char* lds, const Gemm g, const Sched& S, const Epi& E, unsigned long long* stamps, const int tid) {
    const int wid = __builtin_amdgcn_readfirstlane(tid >> 6), lane = tid & 63, wr = wid >> 2, wc = wid & 3, fr = lane & 15, fq = lane >> 4;
    const int K = g.K, nt = K / BK;
    int ts_lo = 0, ts_hi = 0, nts = 0; const unsigned long long rt_entry = STAMP ? (unsigned long long)wall_clock64() : 0ull;
#define PG8_STAMP() do { if (STAMP && wid == 0 && nts < 64) { const unsigned long long _c = (unsigned long long)clock64(); \
        ts_lo = (lane == nts) ? (int)(unsigned)_c : ts_lo; ts_hi = (lane == nts) ? (int)(unsigned)(_c >> 32) : ts_hi; ++nts; } } while (0)
    PG8_STAMP();
    unsigned voffA[2], voffB[2];
#pragma unroll
    for (int i = 0; i < 2; ++i) { int R, C; stage_rc(tid * 16 + i * 8192, R, C); const int Rb = Epi::PERM ? ((R & ~31) + perm32(R & 31)) : R;
        voffA[i] = (unsigned)(R * g.lda + C) * 2u; voffB[i] = (unsigned)(Rb * K + C) * 2u; }
    const size_t kstep = (size_t)(BK * 2);
    const size_t hstep = (size_t)HALF * K * 2;
    const size_t tstep = 2 * hstep;
    const size_t hstepA = (size_t)HALF * g.lda * 2, tstepA = 2 * hstepA;
    const unsigned ldsw = (unsigned)wid * 1024u;
    const int aoff = lds_byte(wr * 64 + fr, fq * 8), boff = lds_byte(wc * 32 + fr, fq * 8);
#define PG8_SA(b, h) (((b) * 2 + (h)) * HTB)
#define PG8_SB(b, h) ((4 + (b) * 2 + (h)) * HTB)
#define PG8_STAGE(bufoff, gbase, voff) do { _Pragma("unroll") for (int _i = 0; _i < 2; ++_i) \
        __builtin_amdgcn_global_load_lds((const unsigned*)((const char*)(gbase) + (voff)[_i]), (PG8_LAS unsigned*)(lds + (bufoff) + ldsw + _i * 8192), 16, 0, 0); } while (0)
#define PG8_LDA(dst, b, h) do { _Pragma("unroll") for (int m = 0; m < 4; ++m) _Pragma("unroll") for (int k = 0; k < 2; ++k) dst[m][k] = *(const PG8_LAS bf16x8*)(lds + PG8_SA(b, h) + aoff + m * 2048 + k * 1024); } while (0)
#define PG8_LDB(dst, b, h) do { _Pragma("unroll") for (int n = 0; n < 2; ++n) _Pragma("unroll") for (int k = 0; k < 2; ++k) dst[n][k] = *(const PG8_LAS bf16x8*)(lds + PG8_SB(b, h) + boff + n * 2048 + k * 1024); } while (0)
#define PG8_MMA(ai, bj, At, Bt) do { __builtin_amdgcn_s_setprio(1); _Pragma("unroll") for (int m = 0; m < 4; ++m) _Pragma("unroll") for (int n = 0; n < 2; ++n) _Pragma("unroll") for (int k = 0; k < 2; ++k) \
        acc[ai][bj][m][n] = __builtin_amdgcn_mfma_f32_16x16x32_bf16(Bt[n][k], At[m][k], acc[ai][bj][m][n], 0, 0, 0); __builtin_amdgcn_s_setprio(0); } while (0)
#define PG8_WAIT_V(n) asm volatile("s_waitcnt vmcnt(" #n ")" ::: "memory")
#define PG8_WAIT_L(n) asm volatile("s_waitcnt lgkmcnt(" #n ")" ::: "memory")
#define PG8_BAR __builtin_amdgcn_s_barrier()
#define PG8_SCHED __builtin_amdgcn_sched_barrier(0)
    Unit cur, nxt; int ui = 0;
    if (!S.next(0, cur)) return;
    f32x4 acc[2][2][4][2];
#pragma unroll
    for (int a = 0; a < 2; ++a)
#pragma unroll
        for (int b = 0; b < 2; ++b)
#pragma unroll
            for (int m = 0; m < 4; ++m)
#pragma unroll
                for (int n = 0; n < 2; ++n) acc[a][b][m][n] = (f32x4){0.f, 0.f, 0.f, 0.f};
    bf16x8 At[4][2], B0[2][2], B1[2][2];
    const char* cA = (const char*)g.A + (size_t)cur.pm * tstepA; const char* cB = (const char*)g.Bt + (size_t)cur.pn * tstep;
#define PG8_SSPF(unit, par) do { if constexpr (Epi::SS_LDS) { __builtin_amdgcn_global_load_lds((const unsigned*)(E.ss + (size_t)(unit).pm * BM + (wid & 3) * 64 + lane), \
        (PG8_LAS unsigned*)(lds + STAGE_BYTES + (par) * 1024 + (wid & 3) * 256), 4, 0, 0); } } while (0)
    S.a_ready(cur);
    PG8_SSPF(cur, 0);
    PG8_STAGE(PG8_SB(0, 0), cB, voffB); PG8_STAGE(PG8_SA(0, 0), cA, voffA); PG8_STAGE(PG8_SB(0, 1), cB + hstep, voffB); PG8_STAGE(PG8_SA(0, 1), cA + hstepA, voffA);
    if (wr == 1) PG8_BAR;
    PG8_WAIT_V(4); PG8_BAR;
    PG8_STAGE(PG8_SB(1, 0), cB + kstep, voffB); PG8_STAGE(PG8_SA(1, 0), cA + kstep, voffA); PG8_STAGE(PG8_SB(1, 1), cB + hstep + kstep, voffB);
    PG8_WAIT_V(6); PG8_BAR;
    PG8_STAMP();
    for (;;) {
        const bool has_next = S.next(ui + 1, nxt);
        const char* nA = has_next ? (const char*)g.A + (size_t)nxt.pm * tstepA : cA; const char* nB = has_next ? (const char*)g.Bt + (size_t)nxt.pn * tstep : cB;
        for (int t = 0; t < nt; t += 2) {
            const bool last = (t == nt - 2);
            const char* a1 = cA + (size_t)(t + 1) * kstep;
            const char* a2 = last ? nA : cA + (size_t)(t + 2) * kstep; const char* b2 = last ? nB : cB + (size_t)(t + 2) * kstep;
            const char* a3 = a2 + kstep; const char* b3 = b2 + kstep;
            if (last && has_next) { S.a_ready(nxt); PG8_SSPF(nxt, (ui + 1) & 1); }
            PG8_LDB(B0, 0, 0); PG8_SCHED; PG8_LDA(At, 0, 0); PG8_STAGE(PG8_SA(1, 1), a1 + hstepA, voffA);
            PG8_WAIT_L(8); PG8_BAR; PG8_WAIT_L(0); PG8_MMA(0, 0, At, B0); PG8_BAR; PG8_SCHED;
            PG8_LDB(B1, 0, 1); PG8_STAGE(PG8_SB(0, 0), b2, voffB);
            PG8_BAR; PG8_WAIT_L(0); PG8_MMA(0, 1, At, B1); PG8_BAR;
            PG8_LDA(At, 0, 1); PG8_STAGE(PG8_SA(0, 0), a2, voffA);
            PG8_BAR; PG8_WAIT_L(0); PG8_MMA(1, 0, At, B0); PG8_BAR; PG8_SCHED;
            PG8_STAGE(PG8_SB(0, 1), b2 + hstep, voffB);
            PG8_WAIT_V(6); PG8_BAR; PG8_MMA(1, 1, At, B1); PG8_BAR;
            PG8_LDB(B0, 1, 0); PG8_SCHED; PG8_LDA(At, 1, 0); PG8_STAGE(PG8_SA(0, 1), a2 + hstepA, voffA);
            PG8_WAIT_L(8); PG8_BAR; PG8_WAIT_L(0); PG8_MMA(0, 0, At, B0); PG8_BAR; PG8_SCHED;
            PG8_LDB(B1, 1, 1); PG8_STAGE(PG8_SB(1, 0), b3, voffB);
            PG8_BAR; PG8_WAIT_L(0); PG8_MMA(0, 1, At, B1); PG8_BAR;
            PG8_LDA(At, 1, 1); PG8_STAGE(PG8_SA(1, 0), a3, voffA);
            PG8_BAR; PG8_WAIT_L(0); PG8_MMA(1, 0, At, B0); PG8_BAR; PG8_SCHED;
            PG8_STAGE(PG8_SB(1, 1), b3 + hstep, voffB);
            PG8_WAIT_V(6); PG8_BAR; PG8_MMA(1, 1, At, B1); PG8_BAR;
        }
        PG8_STAMP();
        if constexpr (!Epi::AFTER_DRAIN) { E(acc, cur, wr, wc, fr, fq, (const volatile PG8_LAS float*)(lds + STAGE_BYTES + (ui & 1) * 1024)); S.done(cur); }
        PG8_STAMP();
        if (!has_next) break;
#pragma unroll
        for (int a = 0; a < 2; ++a)
#pragma unroll
            for (int b = 0; b < 2; ++b)
#pragma unroll
                for (int m = 0; m < 4; ++m)
#pragma unroll
                    for (int n = 0; n < 2; ++n) acc[a][b][m][n] = (f32x4){0.f, 0.f, 0.f, 0.f};
        cur = nxt; cA = nA; cB = nB; ++ui;
    }
    PG8_WAIT_V(0);
    if (wr == 0) PG8_BAR;
    PG8_BAR;
    if constexpr (Epi::AFTER_DRAIN) { E.fused(acc, cur, wr, wc, fr, fq, lds, wid, lane); S.done(cur); }
    PG8_STAMP();
    if (STAMP && wid == 0) { stamps[lane] = lane < nts ? (((unsigned long long)(unsigned)ts_hi << 32) | (unsigned)ts_lo) : 0ull;
        if (lane == 62) stamps[62] = rt_entry; if (lane == 63) stamps[63] = (unsigned long long)wall_clock64(); }
#undef PG8_STAMP
#undef PG8_SA
#undef PG8_SB
#undef PG8_STAGE
#undef PG8_SSPF
#undef PG8_LDA
#undef PG8_LDB
#undef PG8_MMA
#undef PG8_WAIT_V
#undef PG8_WAIT_L
#undef PG8_BAR
#undef PG8_SCHED
}
}

#ifndef PROBE_MASK
#define PROBE_MASK 0
#endif
#ifndef PROBE_N
#define PROBE_N 2
#endif
#ifndef PROBE_PART
#define PROBE_PART 0
#endif

using pg8::bf16_t; using pg8::f32x4; using pg8::u32x4; using pg8::cvt_pk_bf16; using pg8::bflo; using pg8::bfhi;
typedef unsigned u32x2 __attribute__((ext_vector_type(2)));
#define LAS __attribute__((address_space(3)))
constexpr int T = 49152, D = 1024, FF = 2816, NBATCH = 24, SEQ = 2048, NPROMPT = 32768;
constexpr int NWAVES = 8, NTHREADS = 512;
constexpr int LDS_BYTES = 147456;
constexpr size_t MiB = 1u << 20;
constexpr size_t WS_SS = 0;
constexpr size_t WS_RPB = 1536 * 1024;
constexpr size_t WS_BAR = 1792 * 1024;
constexpr size_t WS_HN = 2 * MiB;
constexpr size_t WS_FT = 10 * MiB;
constexpr size_t WS_WGU = 14 * MiB;
constexpr size_t WS_WD = 58 * MiB;
constexpr size_t WS_WIN = 80 * MiB;
constexpr size_t WS_WMO = 84 * MiB;
constexpr size_t WS_WQKV = 86 * MiB;
constexpr size_t WS_WO = 92 * MiB;
constexpr size_t WS_XB = 96 * MiB;
constexpr size_t WS_BIG = 192 * MiB;
constexpr size_t WS_END = 480 * MiB;
constexpr size_t BIG_Z = 192 * MiB, BIG_YT = 240 * MiB;
constexpr size_t OUT_MID = 0, OUT_X0 = 96 * MiB;

__device__ __forceinline__ float wave_sum(float v) {
#pragma unroll
    for (int o = 1; o < 64; o <<= 1) v += __shfl_xor(v, o);
    return v;
}
__device__ __forceinline__ float wave_max(float v) {
#pragma unroll
    for (int o = 1; o < 64; o <<= 1) v = fmaxf(v, __shfl_xor(v, o));
    return v;
}
__device__ __forceinline__ unsigned f2bf(float f) { unsigned u = __float_as_uint(f); return (u + 0x7fffu + ((u >> 16) & 1u)) >> 16; }
__device__ __forceinline__ float bf2f(bf16_t b) { return __uint_as_float((unsigned)b << 16); }
#define LDS_WAIT() asm volatile("s_waitcnt lgkmcnt(0)" ::: "memory")

#define XB_TMO      128
#define XB_XCNT(j)  (256  + 64 * (j))
#define XB_XSUB(j)  (1280 + 64 * (j))
#define XB_XGEN(j)  (2304 + 64 * (j))
#define XB_TOP      3328
#define XB_TOPGEN   3392
#define XCD_BAR_WORDS 3456
#define XB_SPIN_CAP (1u << 18)

__device__ __forceinline__ unsigned xb_ld(unsigned* p)              { return __hip_atomic_load(p, __ATOMIC_RELAXED, __HIP_MEMORY_SCOPE_AGENT); }
__device__ __forceinline__ unsigned xb_add(unsigned* p, unsigned v) { return __hip_atomic_fetch_add(p, v, __ATOMIC_RELAXED, __HIP_MEMORY_SCOPE_AGENT); }
__device__ __forceinline__ unsigned xb_xcc_id() { return (unsigned)__builtin_amdgcn_s_getreg((3 << 11) | 20) & 0xFu; }
#define XB_SPIN(cond, bar) do { unsigned _sp = 0; while (cond) { __builtin_amdgcn_s_sleep(1); \
    if ((++_sp & 255u) == 0u) { if (xb_ld(&(bar)[XB_TMO])) break; if (_sp > XB_SPIN_CAP) { atomicAdd(&(bar)[XB_TMO], 1u); break; } } } } while (0)

struct XcdBarrier {
    unsigned* bar; unsigned x;
    volatile LAS unsigned* st;
};

__device__ __forceinline__ XcdBarrier xcd_barrier_post(unsigned* bar, volatile LAS unsigned* st) {
    XcdBarrier b; b.bar = bar; b.x = xb_xcc_id(); b.st = st;
    if (threadIdx.x == 0) (void)xb_add(&bar[XB_XCNT(b.x)], 1u);
    return b;
}
__device__ __forceinline__ void xcd_barrier_complete(unsigned* bar, unsigned x, unsigned& nloc, unsigned& nx) {
    const unsigned G = gridDim.x * gridDim.y * gridDim.z;
    unsigned sum, cnt, mine, sp = 0u;
    for (;;) {
        sum = 0u; cnt = 0u; mine = 0u;
#pragma unroll
        for (unsigned j = 0; j < 16; ++j) { const unsigned c = xb_ld(&bar[XB_XCNT(j)]); sum += c; cnt += (c > 0u) ? 1u : 0u; mine = (j == x) ? c : mine; }
        if (sum == G) break;
        __builtin_amdgcn_s_sleep(1);
        if ((++sp & 255u) == 0u) { if (xb_ld(&bar[XB_TMO])) break; if (sp > XB_SPIN_CAP) { atomicAdd(&bar[XB_TMO], 1u); break; } }
    }
    nloc = mine > 0u ? mine : 1u; nx = cnt > 0u ? cnt : 1u;
}

__device__ __forceinline__ void xcd_barrier(const XcdBarrier& b) {
    asm volatile("s_waitcnt vmcnt(0)" ::: "memory");
    __syncthreads();
    if (threadIdx.x == 0) {
        unsigned* bar = b.bar;
        __builtin_amdgcn_s_waitcnt(0);
        unsigned nloc = b.st[0], nx = b.st[1];
        if (nloc == 0u) { xcd_barrier_complete(bar, b.x, nloc, nx); b.st[0] = nloc; b.st[1] = nx; }
        const unsigned old = xb_add(&bar[XB_XSUB(b.x)], 1u);
        const unsigned gen = old / nloc;
        if (old + 1u == (gen + 1u) * nloc) {
            __builtin_amdgcn_fence(__ATOMIC_RELEASE, "agent");
            asm volatile("s_waitcnt vmcnt(0)" ::: "memory");
            const unsigned og = xb_add(&bar[XB_TOP], 1u);
            const unsigned tg = og / nx;
            if (og + 1u == (tg + 1u) * nx) xb_add(&bar[XB_TOPGEN], 1u);
            else XB_SPIN(xb_ld(&bar[XB_TOPGEN]) == tg, bar);
            __builtin_amdgcn_fence(__ATOMIC_ACQUIRE, "agent");
            xb_add(&bar[XB_XGEN(b.x)], 1u);
            asm volatile("s_waitcnt vmcnt(0)" ::: "memory");
        } else {
            XB_SPIN(xb_ld(&bar[XB_XGEN(b.x)]) == gen, bar);
            __builtin_amdgcn_fence(__ATOMIC_ACQUIRE, "agent");
            asm volatile("s_waitcnt vmcnt(0)" ::: "memory");
        }
    }
    __syncthreads();
}


struct Args { const float* in[27]; float* out; unsigned char* ws; int ph_lo, ph_hi, rep_mask, rep_n; };
typedef const Args __attribute__((address_space(4)))* CArgsP;

__device__ __forceinline__ void transpose_item(const float* W, int N, const float* ks, bf16_t* WT, int ldd, int koff, int gu, int rowadd, LAS float* scr, int item, int lane) {
    const int nblk = N / 32, kb = item / nblk, nb = item % nblk, k0 = 64 * kb, n0 = 32 * nb;
    {
        const int r8 = lane >> 3, c4 = lane & 7;
        f32x4 wv[8];
#pragma unroll
        for (int i = 0; i < 8; ++i) wv[i] = *(const f32x4*)(W + (size_t)(k0 + 8 * i + r8) * N + n0 + 4 * c4);
#pragma unroll
        for (int i = 0; i < 8; ++i) { const int kk = 8 * i + r8; const float sc = ks ? ks[k0 + kk] : 1.0f; LAS float* d = scr + kk * 33 + 4 * c4;
            d[0] = wv[i][0] * sc; d[1] = wv[i][1] * sc; d[2] = wv[i][2] * sc; d[3] = wv[i][3] * sc; }
    }
    LDS_WAIT();
    const int c = lane & 7;
#pragma unroll
    for (int j = 0; j < 4; ++j) { const int n = (lane >> 3) + 8 * j; const LAS float* s = scr + (8 * c) * 33 + n;
        u32x4 o; o.x = cvt_pk_bf16(s[0 * 33], s[1 * 33]); o.y = cvt_pk_bf16(s[2 * 33], s[3 * 33]); o.z = cvt_pk_bf16(s[4 * 33], s[5 * 33]); o.w = cvt_pk_bf16(s[6 * 33], s[7 * 33]);
        const int nn = n0 + n; const int row = gu ? (256 * (nn >> 7) + (nn & 127) + rowadd) : (nn + rowadd);
        *(u32x4*)(WT + (size_t)row * ldd + koff + k0 + 8 * c) = o; }
    LDS_WAIT();
}
__device__ __forceinline__ void conv_matrix(const float* W, int K, int N, const float* ks, bf16_t* WT, int ldd, int koff, int gu, int rowadd, LAS float* scr, int gw, int NGW, int lane, int& off) {
    const int nitems = (K / 64) * (N / 32);
    int it0 = (gw - off) % NGW; if (it0 < 0) it0 += NGW;
    for (int it = it0; it < nitems; it += NGW) transpose_item(W, N, ks, WT, ldd, koff, gu, rowadd, scr, it, lane);
    off = (off + nitems) % NGW;
}

__device__ __forceinline__ void p0_prologue(CArgsP a, LAS unsigned char* lds, int tid, int lane, int wave, int G) {
    unsigned char* ws = a->ws;
    const int gw = blockIdx.x * NWAVES + wave, NGW = G * NWAVES;
    const int gtid = blockIdx.x * NTHREADS + tid, GT = G * NTHREADS;
    float* SS = (float*)(ws + WS_SS);
    for (int i = gtid; i < 5 * T; i += GT) SS[T + i] = 0.f;
    {
        const float* rpb = a->in[25]; float* rpp = (float*)(ws + WS_RPB);
        for (int i = gtid; i < 16 * 15 * 64; i += GT) { const int dc = (i & 63) - 16; rpp[i] = (dc >= 0 && dc < 31) ? rpb[(i >> 6) * 31 + dc] * 1.4426950408889634f : 0.f; }
    }
    for (int rp_ = 0; rp_ < (PROBE_PART == 1 ? 5 : 1); ++rp_) {
        bf16_t* XB = (bf16_t*)(ws + WS_XB);
        for (int m0 = gw; m0 < T; m0 += 2 * NGW) {
            const int m1 = m0 + NGW; const bool has1 = m1 < T;
            const float* xr0 = (m0 < NPROMPT) ? a->in[0] + (size_t)m0 * D : a->in[1] + (size_t)(m0 - NPROMPT) * D;
            const float* xr1 = has1 ? ((m1 < NPROMPT) ? a->in[0] + (size_t)m1 * D : a->in[1] + (size_t)(m1 - NPROMPT) * D) : xr0;
            f32x4 v[4], w[4]; float s = 0.f, s1 = 0.f;
#pragma unroll
            for (int j = 0; j < 4; ++j) { v[j] = ((const f32x4*)xr0)[64 * j + lane]; w[j] = ((const f32x4*)xr1)[64 * j + lane]; }
#pragma unroll
            for (int j = 0; j < 4; ++j) { s += (v[j].x * v[j].x + v[j].y * v[j].y) + (v[j].z * v[j].z + v[j].w * v[j].w); s1 += (w[j].x * w[j].x + w[j].y * w[j].y) + (w[j].z * w[j].z + w[j].w * w[j].w); }
            s = wave_sum(s); s1 = wave_sum(s1);
#pragma unroll
            for (int j = 0; j < 4; ++j) { u32x2 o; o.x = cvt_pk_bf16(v[j].x, v[j].y); o.y = cvt_pk_bf16(v[j].z, v[j].w); ((u32x2*)(XB + (size_t)m0 * D))[64 * j + lane] = o; }
            if (lane == 0) SS[m0] = s;
            if (has1) {
#pragma unroll
                for (int j = 0; j < 4; ++j) { u32x2 o; o.x = cvt_pk_bf16(w[j].x, w[j].y); o.y = cvt_pk_bf16(w[j].z, w[j].w); ((u32x2*)(XB + (size_t)m1 * D))[64 * j + lane] = o; }
                if (lane == 0) SS[m1] = s1;
            }
        }
    }
    for (int rp_ = 0; rp_ < (PROBE_PART == 2 ? 5 : 1); ++rp_) {
        LAS float* scr = (LAS float*)(lds + wave * 16384);
        int off = 0;
        const float* ng = a->in[2];
        for (int f = 0; f < 4; ++f) {
            const int layer = f >> 1, j = f & 1;
            const float* gain = ng + (size_t)(layer * 3 + (j ? 2 : 0)) * D;
            bf16_t* wgu = (bf16_t*)(ws + WS_WGU) + (size_t)f * 5632 * 1024;
            bf16_t* wd = (bf16_t*)(ws + WS_WD) + (size_t)f * 1024 * 2816;
            conv_matrix(a->in[3] + (size_t)f * D * FF, D, FF, gain, wgu, D, 0, 1, 0, scr, gw, NGW, lane, off);
            conv_matrix(a->in[4] + (size_t)f * D * FF, D, FF, gain, wgu, D, 0, 1, 128, scr, gw, NGW, lane, off);
            conv_matrix(a->in[5] + (size_t)f * FF * D, FF, D, nullptr, wd, FF, 0, 0, 0, scr, gw, NGW, lane, off);
        }
        conv_matrix(a->in[6], D, 2048, ng + 1 * D, (bf16_t*)(ws + WS_WIN), D, 0, 0, 0, scr, gw, NGW, lane, off);
        conv_matrix(a->in[22], D, 3072, ng + 4 * D, (bf16_t*)(ws + WS_WQKV), D, 0, 0, 0, scr, gw, NGW, lane, off);
        conv_matrix(a->in[26], D, D, nullptr, (bf16_t*)(ws + WS_WO), D, 0, 0, 0, scr, gw, NGW, lane, off);
        conv_matrix(a->in[21] + (size_t)512 * D, 512, D, nullptr, (bf16_t*)(ws + WS_WMO), D, 512, 0, 0, scr, gw, NGW, lane, off);
    }
    for (int rp_ = 0; rp_ < (PROBE_PART == 3 ? 5 : 1); ++rp_) {
        const float* pw = a->in[7]; const float* psc = a->in[8]; const float* wout = a->in[21];
        bf16_t* wmo = (bf16_t*)(ws + WS_WMO);
        for (int item = gw; item < 512 * 16; item += NGW) {
            const int k = item >> 4, nb = item & 15, g = k >> 7, n = nb * 64 + lane;
            const float pa = pw[(size_t)k * 128 + lane] * psc[g * 128 + lane], pb = pw[(size_t)k * 128 + 64 + lane] * psc[g * 128 + 64 + lane];
            const float* wr = wout + (size_t)(g * 128) * D + n;
            float s = 0.f;
#pragma unroll 16
            for (int d = 0; d < 64; ++d) s += __shfl(pa, d) * wr[(size_t)d * D];
#pragma unroll 16
            for (int d = 0; d < 64; ++d) s += __shfl(pb, d) * wr[(size_t)(64 + d) * D];
            wmo[(size_t)n * D + k] = (bf16_t)f2bf(s);
        }
    }
    for (int rp_ = 0; rp_ < (PROBE_PART == 4 ? 5 : 1); ++rp_) {
        const float *w1 = a->in[11], *b1 = a->in[12], *w2 = a->in[13], *b2 = a->in[14], *w3 = a->in[15], *b3 = a->in[16], *freq = a->in[17], *wo = a->in[18], *deltas = a->in[19], *hbias = a->in[20];
        bf16_t* FT = (bf16_t*)(ws + WS_FT);
        for (int t = gw; t < SEQ; t += NGW) {
            const float tn = (float)t / 2047.0f;
            float zval = 0.f;
            if (lane == 0) zval = tn;
            else if (lane <= 32) {
                const int bi = (lane - 1) & 15;
                const float band = 1e-4f + (float)bi * ((15.0f - 1e-4f) / 15.0f);
                const float ang = (6.283185307179586f / 2048.0f) * (float)t * band;
                zval = (lane <= 16) ? cosf(ang) : -sinf(ang);
            }
            const float fr = freq[lane];
            const float bb1 = b1[lane], bb2 = b2[lane], bb3 = b3[lane];
            float pre = bb1, h;
#pragma unroll
            for (int ic = 0; ic < 2; ++ic) {
                const float* wp = w1 + ic * 16 * 64 + lane; asm volatile("" : "+v"(wp));
                float wc[16];
#pragma unroll
                for (int i = 0; i < 16; ++i) wc[i] = wp[i * 64];
                __builtin_amdgcn_sched_barrier(0);
#pragma unroll
                for (int i = 0; i < 16; ++i) pre += __shfl(zval, ic * 16 + i) * wc[i];
                __builtin_amdgcn_sched_barrier(0);
            }
            pre += __shfl(zval, 32) * w1[32 * 64 + lane];
            h = sinf(fr * pre);
            pre = bb2;
#pragma unroll
            for (int ic = 0; ic < 4; ++ic) {
                const float* wp = w2 + ic * 16 * 64 + lane; asm volatile("" : "+v"(wp));
                float wc[16];
#pragma unroll
                for (int i = 0; i < 16; ++i) wc[i] = wp[i * 64];
                __builtin_amdgcn_sched_barrier(0);
#pragma unroll
                for (int i = 0; i < 16; ++i) pre += __shfl(h, ic * 16 + i) * wc[i];
                __builtin_amdgcn_sched_barrier(0);
            }
            h = sinf(fr * pre);
            pre = bb3;
#pragma unroll
            for (int ic = 0; ic < 4; ++ic) {
                const float* wp = w3 + ic * 16 * 64 + lane; asm volatile("" : "+v"(wp));
                float wc[16];
#pragma unroll
                for (int i = 0; i < 16; ++i) wc[i] = wp[i * 64];
                __builtin_amdgcn_sched_barrier(0);
#pragma unroll
                for (int i = 0; i < 16; ++i) pre += __shfl(h, ic * 16 + i) * wc[i];
                __builtin_amdgcn_sched_barrier(0);
            }
            h = sinf(fr * pre);
            float o[16];
#pragma unroll
            for (int q = 0; q < 16; ++q) o[q] = 0.f;
#pragma unroll 1
            for (int ib = 0; ib < 16; ++ib) {
                float wv[4][16];
#pragma unroll
                for (int ii = 0; ii < 4; ++ii) {
                    const float* wp = wo + (ib * 4 + ii) * 1024 + lane; asm volatile("" : "+v"(wp));
#pragma unroll
                    for (int q = 0; q < 16; ++q) wv[ii][q] = wp[64 * q];
                }
                __builtin_amdgcn_sched_barrier(0);
#pragma unroll
                for (int ii = 0; ii < 4; ++ii) { const float hv = __shfl(h, ib * 4 + ii);
#pragma unroll
                    for (int q = 0; q < 16; ++q) o[q] += hv * wv[ii][q]; }
                __builtin_amdgcn_sched_barrier(0);
            }
#pragma unroll
            for (int q = 0; q < 16; ++q) {
                const int c2 = lane + 64 * q;
                const float val = o[q] * (__expf(-tn * fabsf(deltas[c2])) + 0.05f);
                const int dir = c2 >> 9, c = c2 & 511;
                if (dir == 0) FT[(size_t)c * 4096 + 2048 - t] = (bf16_t)f2bf(t ? val : val + hbias[c]);
                else FT[(size_t)c * 4096 + (t ? 2048 + t : 0)] = (bf16_t)(t ? f2bf(val) : 0u);
            }
        }
    }
}

__device__ __forceinline__ void sc_load(const bf16_t* P, int tile, int li, int cj, u32x4 (&v)[3][3]) {
    const int ct = tile & 7, lt = (tile >> 3) & 31, b = tile >> 8;
    const int l = lt * 64 + li, c = ct * 64 + cj * 8; const size_t t = (size_t)b * SEQ + l;
    const u32x4 zero = (u32x4){0u, 0u, 0u, 0u};
#pragma unroll
    for (int sg = 0; sg < 3; ++sg) {
        const bf16_t* pc = P + t * 2048 + 512 + sg * 512 + c;
        v[sg][0] = (l > 0) ? *(const u32x4*)(pc - 2048) : zero;
        v[sg][1] = *(const u32x4*)pc;
        v[sg][2] = (l < SEQ - 1) ? *(const u32x4*)(pc + 2048) : zero;
    }
}
__device__ __forceinline__ void elt0_phase(CArgsP a, LAS unsigned char* lds, int tid, int G) {
    const int gtid = blockIdx.x * NTHREADS + tid, GT = G * NTHREADS;
    const bf16_t* P = (const bf16_t*)(a->ws + WS_BIG);
    bf16_t* MIDp = (bf16_t*)((unsigned char*)a->out + OUT_MID);
    bf16_t* X0 = (bf16_t*)((unsigned char*)a->out + OUT_X0);
    bf16_t* ZT = (bf16_t*)(a->ws + WS_BIG + BIG_Z);
    const float* sw = a->in[9]; const float* sb = a->in[10];
    for (int idx = gtid; idx < T * 64; idx += GT) {
        const int c8 = idx & 63, t = idx >> 6, l = t & (SEQ - 1), c = c8 * 8;
        const int g = c8 >> 4, hw = 1 << g;
        const bf16_t* base = P + (size_t)t * 2048 + c;
        u32x4 rv[16];
        int cnt = 0;
#pragma unroll
        for (int q = -8; q < 8; ++q) {
            const int pos = l + q;
            const bool ok = (q >= -hw) && (q < hw) && (pos >= 0) && (pos < SEQ);
            rv[q + 8] = (u32x4){0u, 0u, 0u, 0u};
            if (ok) { rv[q + 8] = *(const u32x4*)(base + (ptrdiff_t)q * 2048); ++cnt; }
        }
        float s[8];
#pragma unroll
        for (int j = 0; j < 8; ++j) s[j] = 0.f;
#pragma unroll
        for (int q = 0; q < 16; ++q) { const u32x4 v = rv[q];
            s[0] += bflo(v.x); s[1] += bfhi(v.x); s[2] += bflo(v.y); s[3] += bfhi(v.y); s[4] += bflo(v.z); s[5] += bfhi(v.z); s[6] += bflo(v.w); s[7] += bfhi(v.w); }
        const float inv = 1.0f / (float)cnt;
        const u32x4 uu = rv[8];
        u32x4 o;
        o.x = cvt_pk_bf16(s[0] * inv - bflo(uu.x), s[1] * inv - bfhi(uu.x)); o.y = cvt_pk_bf16(s[2] * inv - bflo(uu.y), s[3] * inv - bfhi(uu.y));
        o.z = cvt_pk_bf16(s[4] * inv - bflo(uu.z), s[5] * inv - bfhi(uu.z)); o.w = cvt_pk_bf16(s[6] * inv - bflo(uu.w), s[7] * inv - bfhi(uu.w));
        *(u32x4*)(MIDp + (size_t)t * 1024 + c) = o;
    }
    LAS bf16_t* zt = (LAS bf16_t*)lds;
    const int li = tid >> 3, cj = tid & 7;
    constexpr int NT = NBATCH * 32 * 8;
    u32x4 vb[3][3];
    if ((int)blockIdx.x < NT) sc_load(P, blockIdx.x, li, cj, vb);
    for (int tile = blockIdx.x; tile < NT; tile += G) {
        u32x4 vn[3][3];
#pragma unroll
        for (int x = 0; x < 3; ++x)
#pragma unroll
            for (int y = 0; y < 3; ++y) vn[x][y] = (u32x4){0u, 0u, 0u, 0u};
        if (tile + G < NT) sc_load(P, tile + G, li, cj, vn);
        const int ct = tile & 7, lt = (tile >> 3) & 31, b = tile >> 8;
        const int l = lt * 64 + li, c = ct * 64 + cj * 8; const size_t t = (size_t)b * SEQ + l;
        float r[3][8];
#pragma unroll
        for (int sg = 0; sg < 3; ++sg) {
            const int cc = sg * 512 + c;
            const u32x4 vm = vb[sg][0], v0 = vb[sg][1], vp = vb[sg][2];
            const f32x4 wa0 = *(const f32x4*)(sw + cc), wa1 = *(const f32x4*)(sw + cc + 4);
            const f32x4 wb0 = *(const f32x4*)(sw + 1536 + cc), wb1 = *(const f32x4*)(sw + 1536 + cc + 4);
            const f32x4 wc0 = *(const f32x4*)(sw + 3072 + cc), wc1 = *(const f32x4*)(sw + 3072 + cc + 4);
            const f32x4 bb0 = *(const f32x4*)(sb + cc), bb1 = *(const f32x4*)(sb + cc + 4);
            r[sg][0] = bflo(vm.x) * wa0[0] + bflo(v0.x) * wb0[0] + bflo(vp.x) * wc0[0] + bb0[0];
            r[sg][1] = bfhi(vm.x) * wa0[1] + bfhi(v0.x) * wb0[1] + bfhi(vp.x) * wc0[1] + bb0[1];
            r[sg][2] = bflo(vm.y) * wa0[2] + bflo(v0.y) * wb0[2] + bflo(vp.y) * wc0[2] + bb0[2];
            r[sg][3] = bfhi(vm.y) * wa0[3] + bfhi(v0.y) * wb0[3] + bfhi(vp.y) * wc0[3] + bb0[3];
            r[sg][4] = bflo(vm.z) * wa1[0] + bflo(v0.z) * wb1[0] + bflo(vp.z) * wc1[0] + bb1[0];
            r[sg][5] = bfhi(vm.z) * wa1[1] + bfhi(v0.z) * wb1[1] + bfhi(vp.z) * wc1[1] + bb1[1];
            r[sg][6] = bflo(vm.w) * wa1[2] + bflo(v0.w) * wb1[2] + bflo(vp.w) * wc1[2] + bb1[2];
            r[sg][7] = bfhi(vm.w) * wa1[3] + bfhi(v0.w) * wb1[3] + bfhi(vp.w) * wc1[3] + bb1[3];
        }
        u32x4 ox;
        ox.x = cvt_pk_bf16(r[0][0], r[0][1]); ox.y = cvt_pk_bf16(r[0][2], r[0][3]); ox.z = cvt_pk_bf16(r[0][4], r[0][5]); ox.w = cvt_pk_bf16(r[0][6], r[0][7]);
        *(u32x4*)(X0 + t * 512 + c) = ox;
#pragma unroll
        for (int j = 0; j < 8; ++j) zt[(cj * 8 + j) * 72 + li] = (bf16_t)f2bf(r[2][j] * r[1][j]);
        __syncthreads();
        {
            const int cr = tid >> 3, ch = tid & 7;
            const u32x4 v = *(const LAS u32x4*)(zt + cr * 72 + ch * 8);
            *(u32x4*)(ZT + ((size_t)(ct * 64 + cr) * NBATCH + b) * SEQ + lt * 64 + ch * 8) = v;
        }
        __syncthreads();
#pragma unroll
        for (int x = 0; x < 3; ++x)
#pragma unroll
            for (int y = 0; y < 3; ++y) vb[x][y] = vn[x][y];
    }
}

typedef float f32x16 __attribute__((ext_vector_type(16)));
typedef short bf16x8 __attribute__((ext_vector_type(8)));
__device__ __forceinline__ void conv_phase(CArgsP a, LAS unsigned char* lds, int tid, int lane, int wave, int G) {
    constexpr int ZSTR = 4112, FSTR = 8256  , F_OFF = NBATCH * ZSTR;
    const bf16_t* FT = (const bf16_t*)(a->ws + WS_FT);
    const bf16_t* ZT = (const bf16_t*)(a->ws + WS_BIG + BIG_Z);
    bf16_t* YT = (bf16_t*)(a->ws + WS_BIG + BIG_YT);
    const int r = lane & 31, h = lane >> 5, q = (-r) & 3;
    const int brow = r < NBATCH ? r : r - 8;
    for (int c = blockIdx.x; c < 512; c += G) {
        __syncthreads();
        {
            const u32x4 v = *(const u32x4*)(FT + (size_t)c * 4096 + tid * 8);
            *(LAS u32x4*)(lds + F_OFF + tid * 16) = v;
            const unsigned wv[4] = {v.x, v.y, v.z, v.w};
#pragma unroll
            for (int qq = 1; qq < 4; ++qq)
#pragma unroll
                for (int j = 0; j < 8; ++j) {
                    const int pos = tid * 8 + j - qq;
                    const bf16_t e = (bf16_t)((j & 1) ? (wv[j >> 1] >> 16) : (wv[j >> 1] & 0xffffu));
                    if (pos >= 0) *(LAS bf16_t*)(lds + F_OFF + qq * FSTR + pos * 2) = e;
                }
        }
#pragma unroll
        for (int i = 0; i < 12; ++i) {
            const int id = tid + 512 * i, row = id >> 8, col = id & 255;
            const u32x4 v = *(const u32x4*)(ZT + ((size_t)c * NBATCH + row) * SEQ + col * 8);
            *(LAS u32x4*)(lds + row * ZSTR + col * 16) = v;
        }
        __syncthreads();
#pragma unroll 1
        for (int gI = 0; gI < 2; ++gI) {
            const int t0 = (wave * 8 + gI * 4) * 32;
            f32x16 acc[4];
#pragma unroll
            for (int i = 0; i < 4; ++i)
#pragma unroll
                for (int e = 0; e < 16; ++e) acc[i][e] = 0.f;
            int boff = brow * ZSTR + 16 * h;
            int aoff = F_OFF + q * FSTR + (2048 - r + 8 * h - q - t0) * 2;
#define DSR64(dst, addr, OFF) asm volatile("ds_read_b64 %0, %1 offset:" #OFF : "=v"(dst) : "v"(addr))
#define DSR128(dst, addr, OFF) asm volatile("ds_read_b128 %0, %1 offset:" #OFF : "=v"(dst) : "v"(addr))
#define CV_H0(B, L0, H0, L1, H1, SB, S0, S0H, S1, S1H) do { DSR128(B, rb, SB); DSR64(L0, ra, S0); DSR64(H0, ra, S0H); DSR64(L1, ra, S1); DSR64(H1, ra, S1H); } while (0)
#define CV_H1(L2, H2, L3, H3, S2, S2H, S3, S3H) do { DSR64(L2, ra, S2); DSR64(H2, ra, S2H); DSR64(L3, ra, S3); DSR64(H3, ra, S3H); } while (0)
#define CV_WAIT5(N, B, L0, H0, L1, H1) asm volatile("s_waitcnt lgkmcnt(" #N ")" : "+v"(B), "+v"(L0), "+v"(H0), "+v"(L1), "+v"(H1))
#define CV_WAIT4(N, L2, H2, L3, H3) asm volatile("s_waitcnt lgkmcnt(" #N ")" : "+v"(L2), "+v"(H2), "+v"(L3), "+v"(H3))
#define CV_MM(B, L, H, j) acc[j] = __builtin_amdgcn_mfma_f32_32x32x16_bf16(__builtin_bit_cast(bf16x8, B), __builtin_bit_cast(bf16x8, ((u32x4){L.x, L.y, H.x, H.y})), acc[j], 0, 0, 0)
            unsigned rb = (unsigned)(__UINTPTR_TYPE__)lds + (unsigned)boff;
            unsigned ra = (unsigned)(__UINTPTR_TYPE__)lds + (unsigned)(aoff - 192);
            u32x4 bP, bQ; u32x2 l0P, h0P, l1P, h1P, l0Q, h0Q, l1Q, h1Q, l2, h2, l3, h3, l2b, h2b, l3b, h3b;
            CV_H0(bP, l0P, h0P, l1P, h1P, 0, 192, 200, 128, 136);
#pragma unroll 1
            for (int s0 = 0; s0 < SEQ; s0 += 32) {
                CV_H1(l2, h2, l3, h3, 64, 72, 0, 8);
                CV_WAIT5(4, bP, l0P, h0P, l1P, h1P);
                CV_MM(bP, l0P, h0P, 0); CV_MM(bP, l1P, h1P, 1);
                CV_H0(bQ, l0Q, h0Q, l1Q, h1Q, 32, 224, 232, 160, 168);
                CV_WAIT4(5, l2, h2, l3, h3);
                CV_MM(bP, l2, h2, 2); CV_MM(bP, l3, h3, 3);
                CV_H1(l2b, h2b, l3b, h3b, 96, 104, 32, 40);
                CV_WAIT5(4, bQ, l0Q, h0Q, l1Q, h1Q);
                CV_MM(bQ, l0Q, h0Q, 0); CV_MM(bQ, l1Q, h1Q, 1);
                rb += 64; ra += 64;
                CV_H0(bP, l0P, h0P, l1P, h1P, 0, 192, 200, 128, 136);
                CV_WAIT4(5, l2b, h2b, l3b, h3b);
                CV_MM(bQ, l2b, h2b, 2); CV_MM(bQ, l3b, h3b, 3);
            }
            asm volatile("s_waitcnt lgkmcnt(0)" ::: "memory");
#undef DSR64
#undef DSR128
#undef CV_H0
#undef CV_H1
#undef CV_WAIT5
#undef CV_WAIT4
#undef CV_MM
#pragma unroll
            for (int i = 0; i < 4; ++i) {
                const int t = t0 + i * 32 + r;
                bf16_t* yp = YT + ((size_t)c * NBATCH + 4 * h) * SEQ + t;
                asm volatile("" : "+v"(yp));
#pragma unroll
                for (int e = 0; e < 12; ++e) {
                    const int bb0 = (e & 3) + 8 * (e >> 2);
                    yp[(size_t)bb0 * SEQ] = (bf16_t)f2bf(acc[i][e]);
                }
            }
        }
    }
}

__device__ __forceinline__ void trn_load(const bf16_t* YT, const bf16_t* X0, int tile, int tid, u32x4& yv, u32x4& xv) {
    const int ct = tile & 7, lt = (tile >> 3) & 31, b = tile >> 8;
    const int cr = tid >> 3, ch = tid & 7;
    yv = *(const u32x4*)(YT + ((size_t)(ct * 64 + cr) * NBATCH + b) * SEQ + lt * 64 + ch * 8);
    xv = *(const u32x4*)(X0 + ((size_t)b * SEQ + lt * 64 + cr) * 512 + ct * 64 + ch * 8);
}
__device__ __forceinline__ void trn_phase(CArgsP a, LAS unsigned char* lds, int tid, int G) {
    const bf16_t* YT = (const bf16_t*)(a->ws + WS_BIG + BIG_YT);
    const bf16_t* X0 = (const bf16_t*)((unsigned char*)a->out + OUT_X0);
    bf16_t* MIDp = (bf16_t*)((unsigned char*)a->out + OUT_MID);
    LAS bf16_t* zt = (LAS bf16_t*)lds;
    const int li = tid >> 3, cj = tid & 7;
    constexpr int NT = NBATCH * 32 * 8;
    u32x4 yv = (u32x4){0u, 0u, 0u, 0u}, xv = yv;
    if ((int)blockIdx.x < NT) trn_load(YT, X0, blockIdx.x, tid, yv, xv);
    for (int tile = blockIdx.x; tile < NT; tile += G) {
        u32x4 yn = (u32x4){0u, 0u, 0u, 0u}, xn = yn;
        if (tile + G < NT) trn_load(YT, X0, tile + G, tid, yn, xn);
        const int ct = tile & 7, lt = (tile >> 3) & 31, b = tile >> 8;
        *(LAS u32x4*)(zt + li * 72 + cj * 8) = yv;
        __syncthreads();
        const int l = lt * 64 + li, c = ct * 64 + cj * 8; const size_t t = (size_t)b * SEQ + l;
        float y[8];
#pragma unroll
        for (int j = 0; j < 8; ++j) y[j] = bf2f(zt[(cj * 8 + j) * 72 + li]);
        u32x4 o;
        o.x = cvt_pk_bf16(y[0] * bflo(xv.x), y[1] * bfhi(xv.x)); o.y = cvt_pk_bf16(y[2] * bflo(xv.y), y[3] * bfhi(xv.y));
        o.z = cvt_pk_bf16(y[4] * bflo(xv.z), y[5] * bfhi(xv.z)); o.w = cvt_pk_bf16(y[6] * bflo(xv.w), y[7] * bfhi(xv.w));
        *(u32x4*)(MIDp + t * 1024 + 512 + c) = o;
        __syncthreads();
        yv = yn; xv = xn;
    }
}

__device__ __forceinline__ void qkn_phase(CArgsP a, LAS unsigned char* lds, int tid, int G) {
    bf16_t* QKV = (bf16_t*)(a->ws + WS_BIG);
    bf16_t* VT = (bf16_t*)((unsigned char*)a->out + OUT_X0);
    bf16_t* KH = (bf16_t*)((unsigned char*)a->out + OUT_MID);
    const float* gk = a->in[24];
    LAS bf16_t* zt = (LAS bf16_t*)lds;
    const int li = tid >> 3, cj = tid & 7;
    const f32x4 gk0 = *(const f32x4*)(gk + cj * 8), gk1 = *(const f32x4*)(gk + cj * 8 + 4);
    constexpr int NT = NBATCH * 32 * 16;
    u32x4 kv = (u32x4){0u, 0u, 0u, 0u}, vv = kv;
    if ((int)blockIdx.x < NT) { const int tile = blockIdx.x; const int h = tile & 15, lt = (tile >> 4) & 31, b = tile >> 9;
        const bf16_t* qp0 = QKV + ((size_t)b * SEQ + lt * 64 + li) * 3072 + h * 64 + cj * 8;
        kv = *(const u32x4*)(qp0 + 1024); vv = *(const u32x4*)(qp0 + 2048); }
    for (int tile = blockIdx.x; tile < NT; tile += G) {
        u32x4 kn = (u32x4){0u, 0u, 0u, 0u}, vn = kn;
        if (tile + G < NT) { const int tl = tile + G; const int h2 = tl & 15, lt2 = (tl >> 4) & 31, b2 = tl >> 9;
            const bf16_t* qp1 = QKV + ((size_t)b2 * SEQ + lt2 * 64 + li) * 3072 + h2 * 64 + cj * 8;
            kn = *(const u32x4*)(qp1 + 1024); vn = *(const u32x4*)(qp1 + 2048); }
        const int h = tile & 15, lt = (tile >> 4) & 31, b = tile >> 9;
        const size_t t = (size_t)b * SEQ + lt * 64 + li;
        bf16_t* qp = QKV + t * 3072 + h * 64 + cj * 8;
        float kf[8] = {bflo(kv.x), bfhi(kv.x), bflo(kv.y), bfhi(kv.y), bflo(kv.z), bfhi(kv.z), bflo(kv.w), bfhi(kv.w)};
        float sk = 0.f;
#pragma unroll
        for (int j = 0; j < 8; ++j) sk += kf[j] * kf[j];
        sk += __shfl_xor(sk, 1); sk += __shfl_xor(sk, 2); sk += __shfl_xor(sk, 4);
        const float rk = rsqrtf(sk * (1.0f / 64.0f) + 1e-6f);
        u32x4 ko;
        ko.x = cvt_pk_bf16(kf[0] * rk * gk0[0], kf[1] * rk * gk0[1]); ko.y = cvt_pk_bf16(kf[2] * rk * gk0[2], kf[3] * rk * gk0[3]);
        ko.z = cvt_pk_bf16(kf[4] * rk * gk1[0], kf[5] * rk * gk1[1]); ko.w = cvt_pk_bf16(kf[6] * rk * gk1[2], kf[7] * rk * gk1[3]);
        *(LAS u32x4*)((LAS unsigned char*)zt + 9216 + li * 144 + cj * 16) = ko;
        const unsigned vw[4] = {vv.x, vv.y, vv.z, vv.w};
#pragma unroll
        for (int j = 0; j < 8; ++j) zt[(cj * 8 + j) * 72 + li] = (bf16_t)((j & 1) ? (vw[j >> 1] >> 16) : (vw[j >> 1] & 0xffffu));
        __syncthreads();
        {
            const int ch = tid >> 6, cr = tid & 63;
            const u32x4 v = *(const LAS u32x4*)(zt + cr * 72 + ch * 8);
            const u32x4 k = *(const LAS u32x4*)((LAS unsigned char*)zt + 9216 + cr * 144 + ch * 16);
            const size_t tb = ((size_t)((b * 16 + h) * 32 + lt) * 8 + ch) * 512 + cr * 8;
            *(u32x4*)(VT + tb) = v;
            *(u32x4*)(KH + tb) = k;
        }
        __syncthreads();
        kv = kn; vv = vn;
    }
}

__device__ __forceinline__ void attn_phase(CArgsP a, LAS unsigned char* lds, int tid, int lane, int wave, int G) {
    const int vcu = (G % 8 == 0) ? ((int)blockIdx.x % 8) * (G / 8) + (int)blockIdx.x / 8 : (int)blockIdx.x;
    const int gw = vcu * NWAVES + wave, NGW = G * NWAVES;
    const bf16_t* QKV = (const bf16_t*)(a->ws + WS_BIG);
    const bf16_t* VT = (const bf16_t*)((unsigned char*)a->out + OUT_X0);
    const bf16_t* KH = (const bf16_t*)((unsigned char*)a->out + OUT_MID);
    bf16_t* OQ = (bf16_t*)(a->ws + WS_BIG) + 1024;
    {
        const f32x4* src = (const f32x4*)(a->ws + WS_RPB);
        for (int i = tid; i < 16 * 15 * 64 / 4; i += NTHREADS) ((LAS f32x4*)lds)[i] = src[i];
        __syncthreads();
    }
    const volatile LAS float* rpl = (const volatile LAS float*)lds;
    LAS unsigned char* ost = lds + 61440 + wave * 2304;
    const int q16 = lane & 15, g = lane >> 4;
    const int keymap0 = 8 * (q16 >> 2) + (q16 & 3);
    const float* gqp = a->in[23] + 8 * g;
    for (int unit = gw; unit < NBATCH * 16 * 32 * 4; unit += NGW) {
        const int w = unit & 3, r = (unit >> 2) & 31, h = (unit >> 7) & 15, b = unit >> 11;
        int s0 = r - 4; s0 = s0 < 0 ? 0 : (s0 > 24 ? 24 : s0);
        int kc0 = 16 * w - 8; kc0 = kc0 < 0 ? 0 : (kc0 > 32 ? 32 : kc0);
        const int cq = 16 * w + q16;
        int cs = cq - 8; cs = cs < 0 ? 0 : (cs > 48 ? 48 : cs);
        const size_t tq = (size_t)b * SEQ + r * 64 + cq;
        const bf16_t* qp = QKV + tq * 3072 + h * 64 + 8 * g;
        const bf16_t* kbase = KH + ((size_t)((b * 16 + h) * 32 + s0) * 8 + g) * 512 + (kc0 + keymap0) * 8;
        const bf16_t* vbase = VT + ((size_t)((b * 16 + h) * 32 + s0) * 8 + (kc0 >> 3) + g) * 512 + q16 * 8;
        const volatile LAS float* bbase = rpl + (h * 15 + (s0 - r + 7)) * 64 + (kc0 + 8 * g - cq + 15 + 16);
        const u32x4 q0 = *(const u32x4*)qp, q1 = *(const u32x4*)(qp + 32);
        const f32x4 gqa0 = *(const f32x4*)gqp, gqa1 = *(const f32x4*)(gqp + 4), gqb0 = *(const f32x4*)(gqp + 32), gqb1 = *(const f32x4*)(gqp + 36);
        bf16x8 kf[8][2][2];
#pragma unroll
        for (int i = 0; i < 8; ++i)
#pragma unroll
            for (int tl = 0; tl < 2; ++tl) {
                const bf16_t* kp = kbase + i * 4096 + tl * 32;
                kf[i][tl][0] = *(const bf16x8*)kp; kf[i][tl][1] = *(const bf16x8*)(kp + 2048);
            }
        __builtin_amdgcn_sched_barrier(0);
        bf16x8 qf0, qf1;
        {
            float qa[8] = {bflo(q0.x), bfhi(q0.x), bflo(q0.y), bfhi(q0.y), bflo(q0.z), bfhi(q0.z), bflo(q0.w), bfhi(q0.w)};
            float qb[8] = {bflo(q1.x), bfhi(q1.x), bflo(q1.y), bfhi(q1.y), bflo(q1.z), bfhi(q1.z), bflo(q1.w), bfhi(q1.w)};
            float sq = 0.f;
#pragma unroll
            for (int j = 0; j < 8; ++j) sq += qa[j] * qa[j] + qb[j] * qb[j];
            sq += __shfl_xor(sq, 16); sq += __shfl_xor(sq, 32);
            const float rq = rsqrtf(sq * (1.0f / 64.0f) + 1e-6f) * (0.125f * 1.4426950408889634f);
            const u32x4 n0 = (u32x4){cvt_pk_bf16(qa[0] * rq * gqa0[0], qa[1] * rq * gqa0[1]), cvt_pk_bf16(qa[2] * rq * gqa0[2], qa[3] * rq * gqa0[3]),
                                     cvt_pk_bf16(qa[4] * rq * gqa1[0], qa[5] * rq * gqa1[1]), cvt_pk_bf16(qa[6] * rq * gqa1[2], qa[7] * rq * gqa1[3])};
            const u32x4 n1 = (u32x4){cvt_pk_bf16(qb[0] * rq * gqb0[0], qb[1] * rq * gqb0[1]), cvt_pk_bf16(qb[2] * rq * gqb0[2], qb[3] * rq * gqb0[3]),
                                     cvt_pk_bf16(qb[4] * rq * gqb1[0], qb[5] * rq * gqb1[1]), cvt_pk_bf16(qb[6] * rq * gqb1[2], qb[7] * rq * gqb1[3])};
            qf0 = __builtin_bit_cast(bf16x8, n0); qf1 = __builtin_bit_cast(bf16x8, n1);
        }
        __builtin_amdgcn_sched_barrier(0);
        f32x4 sT[8][2];
#pragma unroll
        for (int i = 0; i < 8; ++i)
#pragma unroll
            for (int tl = 0; tl < 2; ++tl) {
                f32x4 acc = (f32x4){0.f, 0.f, 0.f, 0.f};
                acc = __builtin_amdgcn_mfma_f32_16x16x32_bf16(kf[i][tl][0], qf0, acc, 0, 0, 0);
                acc = __builtin_amdgcn_mfma_f32_16x16x32_bf16(kf[i][tl][1], qf1, acc, 0, 0, 0);
                sT[i][tl] = acc;
            }
        __builtin_amdgcn_sched_barrier(0);
        f32x4 bs[8][2];
#pragma unroll
        for (int i = 0; i < 8; ++i)
#pragma unroll
            for (int e = 0; e < 4; ++e) { bs[i][0][e] = bbase[i * 64 + e]; bs[i][1][e] = bbase[i * 64 + 4 + e]; }
        float mx = -1e30f;
#pragma unroll
        for (int i = 0; i < 8; ++i)
#pragma unroll
            for (int tl = 0; tl < 2; ++tl)
#pragma unroll
                for (int e = 0; e < 4; ++e) {
                    const int kc = kc0 + 8 * g + tl * 4 + e;
                    const bool valid = (kc >= cs) && (kc < cs + 16);
                    const float v = valid ? sT[i][tl][e] + bs[i][tl][e] : -1e30f;
                    sT[i][tl][e] = v; mx = fmaxf(mx, v);
                }
        __builtin_amdgcn_sched_barrier(0);
        bf16x8 vf[8][4];
#pragma unroll
        for (int i = 0; i < 8; ++i)
#pragma unroll
            for (int dt = 0; dt < 4; ++dt) vf[i][dt] = *(const bf16x8*)(vbase + i * 4096 + dt * 128);
        __builtin_amdgcn_sched_barrier(0);
        mx = fmaxf(mx, __shfl_xor(mx, 16)); mx = fmaxf(mx, __shfl_xor(mx, 32));
        float sum = 0.f;
        bf16x8 pf[8];
#pragma unroll
        for (int i = 0; i < 8; ++i) {
            float e[8];
#pragma unroll
            for (int j = 0; j < 8; ++j) { e[j] = __builtin_amdgcn_exp2f(sT[i][j >> 2][j & 3] - mx); sum += e[j]; }
            const u32x4 pv = (u32x4){cvt_pk_bf16(e[0], e[1]), cvt_pk_bf16(e[2], e[3]), cvt_pk_bf16(e[4], e[5]), cvt_pk_bf16(e[6], e[7])};
            pf[i] = __builtin_bit_cast(bf16x8, pv);
        }
        sum += __shfl_xor(sum, 16); sum += __shfl_xor(sum, 32);
        __builtin_amdgcn_sched_barrier(0);
        f32x4 o[4];
#pragma unroll
        for (int dt = 0; dt < 4; ++dt) o[dt] = (f32x4){0.f, 0.f, 0.f, 0.f};
#pragma unroll
        for (int i = 0; i < 8; ++i)
#pragma unroll
            for (int dt = 0; dt < 4; ++dt) o[dt] = __builtin_amdgcn_mfma_f32_16x16x32_bf16(vf[i][dt], pf[i], o[dt], 0, 0, 0);
        const float inv = 1.0f / sum;
#pragma unroll
        for (int dt = 0; dt < 4; ++dt) {
            u32x2 ov; ov.x = cvt_pk_bf16(o[dt][0] * inv, o[dt][1] * inv); ov.y = cvt_pk_bf16(o[dt][2] * inv, o[dt][3] * inv);
            *(LAS u32x2*)(ost + q16 * 144 + (dt * 16 + 4 * g) * 2) = ov;
        }
        {
            const int qq = lane >> 2, sg = lane & 3;
            const u32x4 r0 = *(const LAS u32x4*)(ost + qq * 144 + sg * 32), r1 = *(const LAS u32x4*)(ost + qq * 144 + sg * 32 + 16);
            bf16_t* op = OQ + ((size_t)b * SEQ + r * 64 + 16 * w + qq) * 3072 + h * 64 + sg * 16;
            *(u32x4*)op = r0; *(u32x4*)(op + 8) = r1;
        }
    }
}

enum PhaseOp { OP_PREP, OP_GU, OP_DN, OP_WIN, OP_ELT0, OP_CONV, OP_TRN, OP_MIXOUT, OP_QKV, OP_QKN, OP_ATTN, OP_WO, OP_NOP };
constexpr int NPHASES = 18 + (PROBE_MASK ? 1 : 0);
__device__ __forceinline__ void phase_info(int ph, int& op, int& f) {
    f = 0;
    switch (ph) {
        case 0: op = OP_PREP; break;
        case 1: op = OP_GU; f = 0; break;  case 2: op = OP_DN; f = 0; break;
        case 3: op = OP_WIN; break;        case 4: op = OP_ELT0; break;      case 5: op = OP_CONV; break;   case 6: op = OP_TRN; break;   case 7: op = OP_MIXOUT; break;
        case 8: op = OP_GU; f = 1; break;  case 9: op = OP_DN; f = 1; break;
        case 10: op = OP_GU; f = 2; break; case 11: op = OP_DN; f = 2; break;
        case 12: op = OP_QKV; break;       case 13: op = OP_QKN; break;      case 14: op = OP_ATTN; break;     case 15: op = OP_WO; break;
        case 16: op = OP_GU; f = 3; break; case 17: op = OP_DN; f = 3; break; default: op = OP_NOP; break;
    }
}

__global__ void __launch_bounds__(NTHREADS, 2) mega_fwd(Args args) {
    extern __shared__ __attribute__((aligned(16))) unsigned char lds_raw[];
    LAS unsigned char* lds = (LAS unsigned char*)lds_raw;
    cg::grid_group grid = cg::this_grid();
    const int G = gridDim.x;
    volatile LAS unsigned* bst = (volatile LAS unsigned*)(lds + (LDS_BYTES - 64));
    if (threadIdx.x < 2) bst[threadIdx.x] = 0u;
    __syncthreads();
    XcdBarrier xbar; xbar.bar = (unsigned*)(args.ws + WS_BAR); xbar.x = 0; xbar.st = bst;
    if (args.ph_hi - args.ph_lo > 1) xbar = xcd_barrier_post((unsigned*)(args.ws + WS_BAR), bst);
    int nseam = 0;
    int ph = args.ph_lo, rep = 0; (void)rep;
    while (ph < args.ph_hi) {
        int tid = threadIdx.x; asm volatile("" : "+v"(tid));
        const int lane = tid & 63, wave = __builtin_amdgcn_readfirstlane(tid >> 6);
        CArgsP ap = (CArgsP)__builtin_amdgcn_kernarg_segment_ptr(); asm volatile("" : "+s"(ap));
        unsigned char* ws = ap->ws;
        unsigned char* outb = (unsigned char*)ap->out;
        float* SS = (float*)(ws + WS_SS);
        bf16_t* XB = (bf16_t*)(ws + WS_XB);
        bf16_t* BIG = (bf16_t*)(ws + WS_BIG);
        bf16_t* MIDp = (bf16_t*)(outb + OUT_MID);
        int op, f; phase_info(ph, op, f);
        if (op == OP_PREP) {
            p0_prologue(ap, lds, tid, lane, wave, G);
        } else if (op == OP_GU) {
            const int ssi = (f == 0) ? 0 : (f == 1) ? 2 : (f == 2) ? 3 : 5;
            pg8::Gemm g{XB, (const bf16_t*)(ws + WS_WGU) + (size_t)f * 5632 * 1024, T, 5632, D, D};
            pg8::StaticOrder S; S.init(T, 5632, G, (int)blockIdx.x);
            pg8::EpiGU E{BIG, FF, SS + (size_t)ssi * T};
            pg8::gemm_phase<pg8::EpiGU, pg8::StaticOrder>(lds, g, S, E, nullptr, tid);
        } else if (op == OP_DN || op == OP_MIXOUT || op == OP_WO) {
            pg8::Gemm g; float alpha; float* ssn; float* outf = nullptr;
            if (op == OP_DN) { g = pg8::Gemm{BIG, (const bf16_t*)(ws + WS_WD) + (size_t)f * 1024 * 2816, T, D, FF, FF}; alpha = 0.5f;
                ssn = (f == 0) ? SS + 1 * (size_t)T : (f == 1) ? SS + 3 * (size_t)T : (f == 2) ? SS + 4 * (size_t)T : nullptr; if (f == 3) outf = (float*)outb; }
            else if (op == OP_MIXOUT) { g = pg8::Gemm{MIDp, (const bf16_t*)(ws + WS_WMO), T, D, D, D}; alpha = 1.0f; ssn = SS + 2 * (size_t)T; }
            else { g = pg8::Gemm{BIG + 1024, (const bf16_t*)(ws + WS_WO), T, D, D, 3072};     alpha = 1.0f; ssn = SS + 5 * (size_t)T; }
            pg8::StaticOrder S; S.init(T, D, G, (int)blockIdx.x);
            pg8::EpiRes E{XB, outf, alpha, ssn};
            pg8::gemm_phase<pg8::EpiRes, pg8::StaticOrder>(lds, g, S, E, nullptr, tid);
        } else if (op == OP_WIN || op == OP_QKV) {
            const int N = (op == OP_WIN) ? 2048 : 3072;
            pg8::Gemm g{XB, (const bf16_t*)(ws + (op == OP_WIN ? WS_WIN : WS_WQKV)), T, N, D, D};
            pg8::StaticOrder S; S.init(T, N, G, (int)blockIdx.x);
            pg8::EpiScale E{BIG, N, SS + (size_t)(op == OP_WIN ? 1 : 4) * T};
            pg8::gemm_phase<pg8::EpiScale, pg8::StaticOrder>(lds, g, S, E, nullptr, tid);
        } else if (op == OP_ELT0) {
            elt0_phase(ap, lds, tid, G);
        } else if (op == OP_CONV) {
            conv_phase(ap, lds, tid, lane, wave, G);
        } else if (op == OP_TRN) {
            trn_phase(ap, lds, tid, G);
        } else if (op == OP_QKN) {
            qkn_phase(ap, lds, tid, G);
        } else if (op == OP_ATTN) {
            attn_phase(ap, lds, tid, lane, wave, G);
        }
#if PROBE_MASK
        if (((ap->rep_mask >> ph) & 1) && rep + 1 < ap->rep_n) ++rep; else { rep = 0; ++ph; }
#else
        ++ph;
#endif
        if (ph < args.ph_hi) {
            if (args.ph_lo < 0) grid.sync();
            xcd_barrier(xbar);
            ++nseam;
        }
    }
}

#ifndef MK_ONE_LAUNCH
#define MK_ONE_LAUNCH 1
#endif
extern "C" void kernel_launch(void* const* d_in, const int* in_sizes, int n_in, void* d_out, int out_size, void* d_ws, size_t ws_size, hipStream_t stream) {
    static int grid = 0;
    if (grid == 0) {
        if (n_in != 27 || out_size != T * D || ws_size < WS_END) { fprintf(stderr, "kernel_launch: unexpected shapes: n_in %d out %d ws %zu\n", n_in, out_size, ws_size); grid = -1; return; }
        int dev = 0, cus = 0, per_cu = 0;
        (void)hipGetDevice(&dev); (void)hipDeviceGetAttribute(&cus, hipDeviceAttributeMultiprocessorCount, dev);
        if (hipFuncSetAttribute((const void*)mega_fwd, hipFuncAttributeMaxDynamicSharedMemorySize, LDS_BYTES) != hipSuccess) { fprintf(stderr, "kernel_launch: hipFuncSetAttribute failed\n"); grid = -1; return; }
        if (hipOccupancyMaxActiveBlocksPerMultiprocessor(&per_cu, (const void*)mega_fwd, NTHREADS, LDS_BYTES) != hipSuccess || per_cu < 1) { fprintf(stderr, "kernel_launch: occupancy query says %d\n", per_cu); per_cu = 1; }
        (void)hipGetLastError();
        grid = cus * per_cu;
        fprintf(stderr, "kernel_launch: grid %d (cus %d x %d)\n", grid, cus, per_cu);
    }
    if (grid < 0) return;
    Args a{};
    for (int i = 0; i < 27; ++i) a.in[i] = (const float*)d_in[i];
    a.out = (float*)d_out; a.ws = (unsigned char*)d_ws; a.rep_mask = PROBE_MASK; a.rep_n = PROBE_N;
#if MK_ONE_LAUNCH
    (void)hipMemsetAsync((unsigned char*)d_ws + WS_BAR, 0, 16384, stream);
    a.ph_lo = 0; a.ph_hi = NPHASES;
    void* kargs[] = {&a};
    hipError_t e = hipLaunchCooperativeKernel((const void*)mega_fwd, dim3(grid), dim3(NTHREADS), kargs, LDS_BYTES, stream);
    if (e != hipSuccess) fprintf(stderr, "kernel_launch: cooperative launch failed: %s (grid %d)\n", hipGetErrorString(e), grid);
#else
    for (int ph = 0; ph < NPHASES; ++ph) {
        a.ph_lo = ph; a.ph_hi = ph + 1;
        hipLaunchKernelGGL(mega_fwd, dim3(grid), dim3(NTHREADS), LDS_BYTES, stream, a);
    }
#endif
}
```

```cpp
#include <hip/hip_runtime.h>
#include <hip/hip_cooperative_groups.h>
#include <cstdio>
namespace cg = cooperative_groups;
namespace pg8 {
#define PG8_LAS __attribute__((address_space(3)))
typedef unsigned short bf16_t;
typedef short bf16x8 __attribute__((ext_vector_type(8)));
typedef float f32x4 __attribute__((ext_vector_type(4)));
typedef unsigned u32x4 __attribute__((ext_vector_type(4)));
constexpr int BM = 256, BK = 64, HALF = 128, HTB = HALF * BK * 2  , STAGE_BYTES = 8 * HTB, NXCD = 8, WGM = 4;

__host__ __device__ __forceinline__ int lds_byte(int r, int c) { const int st = (r >> 4) * 2 + (c >> 5), rr = r & 15, cc = c & 31, ob = rr * 64 + cc * 2; return st * 1024 + (ob ^ (((ob >> 9) & 1) << 5)); }
__host__ __device__ __forceinline__ void stage_rc(int b, int& R, int& C) { const int st = b / 1024, sb = b % 1024, swz = sb ^ (((sb >> 9) & 1) << 5); R = (st >> 1) * 16 + swz / 64; C = (st & 1) * 32 + (swz % 64) / 2; }
__host__ __device__ __forceinline__ int perm32(int rho) { const int n = rho >> 4, i = rho & 15; return 8 * (i >> 2) + 4 * n + (i & 3); }

struct Unit { int pm, pn; };
struct Gemm { const bf16_t* A; const bf16_t* Bt; int M, N, K, lda; };

struct StaticOrder {
    int nM, nN, nwg, G, c;
    __host__ __device__ void init(int M, int N, int G_, int c_) { nM = M / BM; nN = N / BM; nwg = nM * nN; G = G_; c = c_; }
    __host__ __device__ bool next(int i, Unit& u) const {
        const long L = (long)i * G + c; if (L >= nwg) return false;
        int wgid = (int)L; { const int q = nwg / NXCD, r = nwg % NXCD, xcd = wgid % NXCD, off = wgid / NXCD; wgid = (xcd < r ? xcd * (q + 1) : r * (q + 1) + (xcd - r) * q) + off; }
        const int nig = WGM * nN, gid = wgid / nig, fm = gid * WGM, gsz = (nM - fm) < WGM ? (nM - fm) : WGM;
        u.pm = fm + ((wgid % nig) % gsz); u.pn = (wgid % nig) / gsz; return true;
    }
    __device__ __forceinline__ void a_ready(const Unit&) const {}
    __device__ __forceinline__ void done(const Unit&) const {}
};
__device__ __forceinline__ unsigned cvt_pk_bf16(float lo, float hi) { unsigned r; asm volatile("v_cvt_pk_bf16_f32 %0, %1, %2" : "=v"(r) : "v"(lo), "v"(hi)); return r; }
typedef float f32x2 __attribute__((ext_vector_type(2)));
__device__ __forceinline__ float silu_f(float g) { return g * __builtin_amdgcn_rcpf(1.0f + __expf(-g)); }
__device__ __forceinline__ float bflo(unsigned w) { return __uint_as_float(w << 16); }
__device__ __forceinline__ float bfhi(unsigned w) { return __uint_as_float(w & 0xffff0000u); }

struct EpiGU {
    static constexpr bool PERM = true, AFTER_DRAIN = false, SS_LDS = true;
    bf16_t* H; int ldh; const float* ss;
    __device__ __forceinline__ void operator()(const f32x4 (&acc)[2][2][4][2], const Unit& u, int wr, int wc, int fr, int fq, const volatile PG8_LAS float* ssl) const {
        const int row0 = u.pm * BM + wr * 64 + fr, col0 = u.pn * HALF + wc * 32 + 8 * fq;
        float ssv[2][4];
#pragma unroll
        for (int ai = 0; ai < 2; ++ai)
#pragma unroll
            for (int m = 0; m < 4; ++m) ssv[ai][m] = ssl[ai * HALF + wr * 64 + m * 16 + fr];
#pragma unroll
        for (int ai = 0; ai < 2; ++ai)
#pragma unroll
            for (int m = 0; m < 4; ++m) {
                const int row = row0 + ai * HALF + m * 16;
                const float rstd = rsqrtf(ssv[ai][m] * (1.0f / 1024.0f) + 1e-6f);
                const float r2 = rstd * rstd, nr = rstd * -1.4426950408889634f;
                unsigned wv[4];
#pragma unroll
                for (int n = 0; n < 2; ++n)
#pragma unroll
                    for (int jp = 0; jp < 2; ++jp) {
                        const f32x2 g = (f32x2){acc[ai][0][m][n][2 * jp], acc[ai][0][m][n][2 * jp + 1]}, uu = (f32x2){acc[ai][1][m][n][2 * jp], acc[ai][1][m][n][2 * jp + 1]};
                        const f32x2 t = g * nr;
                        f32x2 e; e.x = __builtin_amdgcn_exp2f(t.x); e.y = __builtin_amdgcn_exp2f(t.y);
                        const f32x2 d = e + 1.0f;
                        f32x2 rc; rc.x = __builtin_amdgcn_rcpf(d.x); rc.y = __builtin_amdgcn_rcpf(d.y);
                        const f32x2 hv = (g * uu) * (rc * r2);
                        wv[n * 2 + jp] = cvt_pk_bf16(hv.x, hv.y);
                    }
                u32x4 w; w.x = wv[0]; w.y = wv[1]; w.z = wv[2]; w.w = wv[3];
                *(u32x4*)(H + (size_t)row * ldh + col0) = w;
            }
    }
};
struct EpiScale {
    static constexpr bool PERM = true, AFTER_DRAIN = false, SS_LDS = true;
    bf16_t* O; int ldc; const float* ss;
    __device__ __forceinline__ void operator()(const f32x4 (&acc)[2][2][4][2], const Unit& u, int wr, int wc, int fr, int fq, const volatile PG8_LAS float* ssl) const {
        const int row0 = u.pm * BM + wr * 64 + fr, col0 = u.pn * BM + wc * 32 + 8 * fq;
        float ssv[2][4];
#pragma unroll
        for (int ai = 0; ai < 2; ++ai)
#pragma unroll
            for (int m = 0; m < 4; ++m) ssv[ai][m] = ssl[ai * HALF + wr * 64 + m * 16 + fr];
#pragma unroll
        for (int ai = 0; ai < 2; ++ai)
#pragma unroll
            for (int m = 0; m < 4; ++m) {
                const int row = row0 + ai * HALF + m * 16;
                const float rstd = rsqrtf(ssv[ai][m] * (1.0f / 1024.0f) + 1e-6f);
#pragma unroll
                for (int bj = 0; bj < 2; ++bj) {
                    const f32x4 v0 = acc[ai][bj][m][0] * rstd, v1 = acc[ai][bj][m][1] * rstd;
                    u32x4 w; w.x = cvt_pk_bf16(v0[0], v0[1]); w.y = cvt_pk_bf16(v0[2], v0[3]); w.z = cvt_pk_bf16(v1[0], v1[1]); w.w = cvt_pk_bf16(v1[2], v1[3]);
                    *(u32x4*)(O + (size_t)row * ldc + col0 + bj * HALF) = w;
                }
            }
    }
};
struct EpiRes {
    static constexpr bool PERM = true, AFTER_DRAIN = false, SS_LDS = false;
    bf16_t* X; float* outf; float alpha; float* ssn;
    __device__ __forceinline__ void operator()(const f32x4 (&acc)[2][2][4][2], const Unit& u, int wr, int wc, int fr, int fq, const volatile PG8_LAS float*) const {
        const int row0 = u.pm * BM + wr * 64 + fr, col0 = u.pn * BM + wc * 32 + 8 * fq;
        if (outf) {
#pragma unroll
            for (int ai = 0; ai < 2; ++ai) {
                u32x4 xold[4][2];
#pragma unroll
                for (int m = 0; m < 4; ++m)
#pragma unroll
                    for (int bj = 0; bj < 2; ++bj) xold[m][bj] = *(const u32x4*)(X + (size_t)(row0 + ai * HALF + m * 16) * 1024 + col0 + bj * HALF);
#pragma unroll
                for (int m = 0; m < 4; ++m)
#pragma unroll
                    for (int bj = 0; bj < 2; ++bj) {
                        const u32x4 xo = xold[m][bj];
                        float* op = outf + (size_t)(row0 + ai * HALF + m * 16) * 1024 + col0 + bj * HALF;
                        *(f32x4*)op = (f32x4){bflo(xo.x) + alpha * acc[ai][bj][m][0][0], bfhi(xo.x) + alpha * acc[ai][bj][m][0][1], bflo(xo.y) + alpha * acc[ai][bj][m][0][2], bfhi(xo.y) + alpha * acc[ai][bj][m][0][3]};
                        *(f32x4*)(op + 4) = (f32x4){bflo(xo.z) + alpha * acc[ai][bj][m][1][0], bfhi(xo.z) + alpha * acc[ai][bj][m][1][1], bflo(xo.w) + alpha * acc[ai][bj][m][1][2], bfhi(xo.w) + alpha * acc[ai][bj][m][1][3]};
                    }
            }
            return;
        }
#define ER_LD(rg) do { _Pragma("unroll") for (int bj_ = 0; bj_ < 2; ++bj_) \
            xb[rg][bj_] = *(const u32x4*)(X + (size_t)(row0 + ((rg) >> 2) * HALF + ((rg) & 3) * 16) * 1024 + col0 + bj_ * HALF); } while (0)
        u32x4 xb[8][2], wq[8][2];
        float sqv[8];
        ER_LD(0); ER_LD(1);
#pragma unroll
        for (int rg = 0; rg < 8; ++rg) {
            if (rg + 2 < 8) ER_LD(rg + 2);
            __builtin_amdgcn_sched_barrier(0);
            const int ai = rg >> 2, m = rg & 3;
            float sq = 0.f;
#pragma unroll
            for (int bj = 0; bj < 2; ++bj) {
                const u32x4 xo = xb[rg][bj];
                u32x4 w;
                w.x = cvt_pk_bf16(bflo(xo.x) + alpha * acc[ai][bj][m][0][0], bfhi(xo.x) + alpha * acc[ai][bj][m][0][1]);
                w.y = cvt_pk_bf16(bflo(xo.y) + alpha * acc[ai][bj][m][0][2], bfhi(xo.y) + alpha * acc[ai][bj][m][0][3]);
                w.z = cvt_pk_bf16(bflo(xo.z) + alpha * acc[ai][bj][m][1][0], bfhi(xo.z) + alpha * acc[ai][bj][m][1][1]);
                w.w = cvt_pk_bf16(bflo(xo.w) + alpha * acc[ai][bj][m][1][2], bfhi(xo.w) + alpha * acc[ai][bj][m][1][3]);
                wq[rg][bj] = w;
                sq += bflo(w.x) * bflo(w.x) + bfhi(w.x) * bfhi(w.x) + bflo(w.y) * bflo(w.y) + bfhi(w.y) * bfhi(w.y)
                    + bflo(w.z) * bflo(w.z) + bfhi(w.z) * bfhi(w.z) + bflo(w.w) * bflo(w.w) + bfhi(w.w) * bfhi(w.w);
            }
            sqv[rg] = sq;
            __builtin_amdgcn_sched_barrier(0);
        }
#undef ER_LD
#pragma unroll
        for (int rg = 0; rg < 8; ++rg) {
            const int row = row0 + (rg >> 2) * HALF + (rg & 3) * 16;
#pragma unroll
            for (int bj = 0; bj < 2; ++bj) *(u32x4*)(X + (size_t)row * 1024 + col0 + bj * HALF) = wq[rg][bj];
            if (ssn) {
                float sq = sqv[rg];
                sq += __shfl_xor(sq, 16); sq += __shfl_xor(sq, 32);
                if (fq == 0) atomicAdd(ssn + row, sq);
            }
        }
    }
};
template <class Epi, class Sched, bool STAMP = false>
__device__ __forceinline__ void gemm_phase(PG8_LAS unsigned char* lds, const Gemm g, const Sched& S, const Epi& E, unsigned long long* stamps, const int tid) {
    const int wid = __builtin_amdgcn_readfirstlane(tid >> 6), lane = tid & 63, wr = wid >> 2, wc = wid & 3, fr = lane & 15, fq = lane >> 4;
    const int K = g.K, nt = K / BK;
    int ts_lo = 0, ts_hi = 0, nts = 0; const unsigned long long rt_entry = STAMP ? (unsigned long long)wall_clock64() : 0ull;
#define PG8_STAMP() do { if (STAMP && wid == 0 && nts < 64) { const unsigned long long _c = (unsigned long long)clock64(); \
        ts_lo = (lane == nts) ? (int)(unsigned)_c : ts_lo; ts_hi = (lane == nts) ? (int)(unsigned)(_c >> 32) : ts_hi; ++nts; } } while (0)
    PG8_STAMP();
    unsigned voffA[2], voffB[2];
#pragma unroll
    for (int i = 0; i < 2; ++i) { int R, C; stage_rc(tid * 16 + i * 8192, R, C); const int Rb = Epi::PERM ? ((R & ~31) + perm32(R & 31)) : R;
        voffA[i] = (unsigned)(R * g.lda + C) * 2u; voffB[i] = (unsigned)(Rb * K + C) * 2u; }
    const size_t kstep = (size_t)(BK * 2);
    const size_t hstep = (size_t)HALF * K * 2;
    const size_t tstep = 2 * hstep;
    const size_t hstepA = (size_t)HALF * g.lda * 2, tstepA = 2 * hstepA;
    const unsigned ldsw = (unsigned)wid * 1024u;
    const int aoff = lds_byte(wr * 64 + fr, fq * 8), boff = lds_byte(wc * 32 + fr, fq * 8);
#define PG8_SA(b, h) (((b) * 2 + (h)) * HTB)
#define PG8_SB(b, h) ((4 + (b) * 2 + (h)) * HTB)
#define PG8_STAGE(bufoff, gbase, voff) do { _Pragma("unroll") for (int _i = 0; _i < 2; ++_i) \
        __builtin_amdgcn_global_load_lds((const unsigned*)((const char*)(gbase) + (voff)[_i]), (PG8_LAS unsigned*)(lds + (bufoff) + ldsw + _i * 8192), 16, 0, 0); } while (0)
#define PG8_LDA(dst, b, h) do { _Pragma("unroll") for (int m = 0; m < 4; ++m) _Pragma("unroll") for (int k = 0; k < 2; ++k) dst[m][k] = *(const PG8_LAS bf16x8*)(lds + PG8_SA(b, h) + aoff + m * 2048 + k * 1024); } while (0)
#define PG8_LDB(dst, b, h) do { _Pragma("unroll") for (int n = 0; n < 2; ++n) _Pragma("unroll") for (int k = 0; k < 2; ++k) dst[n][k] = *(const PG8_LAS bf16x8*)(lds + PG8_SB(b, h) + boff + n * 2048 + k * 1024); } while (0)
#define PG8_MMA(ai, bj, At, Bt) do { __builtin_amdgcn_s_setprio(1); _Pragma("unroll") for (int m = 0; m < 4; ++m) _Pragma("unroll") for (int n = 0; n < 2; ++n) _Pragma("unroll") for (int k = 0; k < 2; ++k) \
        acc[ai][bj][m][n] = __builtin_amdgcn_mfma_f32_16x16x32_bf16(Bt[n][k], At[m][k], acc[ai][bj][m][n], 0, 0, 0); __builtin_amdgcn_s_setprio(0); } while (0)
#define PG8_WAIT_V(n) asm volatile("s_waitcnt vmcnt(" #n ")" ::: "memory")
#define PG8_WAIT_L(n) asm volatile("s_waitcnt lgkmcnt(" #n ")" ::: "memory")
#define PG8_BAR __builtin_amdgcn_s_barrier()
#define PG8_SCHED __builtin_amdgcn_sched_barrier(0)
    Unit cur, nxt; int ui = 0;
    if (!S.next(0, cur)) return;
    f32x4 acc[2][2][4][2];
#pragma unroll
    for (int a = 0; a < 2; ++a)
#pragma unroll
        for (int b = 0; b < 2; ++b)
#pragma unroll
            for (int m = 0; m < 4; ++m)
#pragma unroll
                for (int n = 0; n < 2; ++n) acc[a][b][m][n] = (f32x4){0.f, 0.f, 0.f, 0.f};
    bf16x8 At[4][2], B0[2][2], B1[2][2];
    const char* cA = (const char*)g.A + (size_t)cur.pm * tstepA; const char* cB = (const char*)g.Bt + (size_t)cur.pn * tstep;
#define PG8_SSPF(unit, par) do { if constexpr (Epi::SS_LDS) { __builtin_amdgcn_global_load_lds((const unsigned*)(E.ss + (size_t)(unit).pm * BM + (wid & 3) * 64 + lane), \
        (PG8_LAS unsigned*)(lds + STAGE_BYTES + (par) * 1024 + (wid & 3) * 256), 4, 0, 0); } } while (0)
    S.a_ready(cur);
    PG8_SSPF(cur, 0);
    PG8_STAGE(PG8_SB(0, 0), cB, voffB); PG8_STAGE(PG8_SA(0, 0), cA, voffA); PG8_STAGE(PG8_SB(0, 1), cB + hstep, voffB); PG8_STAGE(PG8_SA(0, 1), cA + hstepA, voffA);
    if (wr == 1) PG8_BAR;
    PG8_WAIT_V(4); PG8_BAR;
    PG8_STAGE(PG8_SB(1, 0), cB + kstep, voffB); PG8_STAGE(PG8_SA(1, 0), cA + kstep, voffA); PG8_STAGE(PG8_SB(1, 1), cB + hstep + kstep, voffB);
    PG8_WAIT_V(6); PG8_BAR;
    PG8_STAMP();
    for (;;) {
        const bool has_next = S.next(ui + 1, nxt);
        const char* nA = has_next ? (const char*)g.A + (size_t)nxt.pm * tstepA : cA; const char* nB = has_next ? (const char*)g.Bt + (size_t)nxt.pn * tstep : cB;
        for (int t = 0; t < nt; t += 2) {
            const bool last = (t == nt - 2);
            const char* a1 = cA + (size_t)(t + 1) * kstep;
            const char* a2 = last ? nA : cA + (size_t)(t + 2) * kstep; const char* b2 = last ? nB : cB + (size_t)(t + 2) * kstep;
            const char* a3 = a2 + kstep; const char* b3 = b2 + kstep;
            if (last && has_next) { S.a_ready(nxt); PG8_SSPF(nxt, (ui + 1) & 1); }
            PG8_LDB(B0, 0, 0); PG8_SCHED; PG8_LDA(At, 0, 0); PG8_STAGE(PG8_SA(1, 1), a1 + hstepA, voffA);
            PG8_WAIT_L(8); PG8_BAR; PG8_WAIT_L(0); PG8_MMA(0, 0, At, B0); PG8_BAR; PG8_SCHED;
            PG8_LDB(B1, 0, 1); PG8_STAGE(PG8_SB(0, 0), b2, voffB);
            PG8_BAR; PG8_WAIT_L(0); PG8_MMA(0, 1, At, B1); PG8_BAR;
            PG8_LDA(At, 0, 1); PG8_STAGE(PG8_SA(0, 0), a2, voffA);
            PG8_BAR; PG8_WAIT_L(0); PG8_MMA(1, 0, At, B0); PG8_BAR; PG8_SCHED;
            PG8_STAGE(PG8_SB(0, 1), b2 + hstep, voffB);
            PG8_WAIT_V(6); PG8_BAR; PG8_MMA(1, 1, At, B1); PG8_BAR;
            PG8_LDB(B0, 1, 0); PG8_SCHED; PG8_LDA(At, 1, 0); PG8_STAGE(PG8_SA(0, 1), a2 + hstepA, voffA);
            PG8_WAIT_L(8); PG8_BAR; PG8_WAIT_L(0); PG8_MMA(0, 0, At, B0); PG8_BAR; PG8_SCHED;
            PG8_LDB(B1, 1, 1); PG8_STAGE(PG8_SB(1, 0), b3, voffB);
            PG8_BAR; PG8_WAIT_L(0); PG8_MMA(0, 1, At, B1); PG8_BAR;
            PG8_LDA(At, 1, 1); PG8_STAGE(PG8_SA(1, 0), a3, voffA);
            PG8_BAR; PG8_WAIT_L(0); PG8_MMA(1, 0, At, B0); PG8_BAR; PG8_SCHED;
            PG8_STAGE(PG8_SB(1, 1), b3 + hstep, voffB);
            PG8_WAIT_V(6); PG8_BAR; PG8_MMA(1, 1, At, B1); PG8_BAR;
        }
        PG8_STAMP();
        if constexpr (!Epi::AFTER_DRAIN) { E(acc, cur, wr, wc, fr, fq, (const volatile PG8_LAS float*)(lds + STAGE_BYTES + (ui & 1) * 1024)); S.done(cur); }
        PG8_STAMP();
        if (!has_next) break;
#pragma unroll
        for (int a = 0; a < 2; ++a)
#pragma unroll
            for (int b = 0; b < 2; ++b)
#pragma unroll
                for (int m = 0; m < 4; ++m)
#pragma unroll
                    for (int n = 0; n < 2; ++n) acc[a][b][m][n] = (f32x4){0.f, 0.f, 0.f, 0.f};
        cur = nxt; cA = nA; cB = nB; ++ui;
    }
    PG8_WAIT_V(0);
    if (wr == 0) PG8_BAR;
    PG8_BAR;
    if constexpr (Epi::AFTER_DRAIN) { E.fused(acc, cur, wr, wc, fr, fq, lds, wid, lane); S.done(cur); }
    PG8_STAMP();
    if (STAMP && wid == 0) { stamps[lane] = lane < nts ? (((unsigned long long)(unsigned)ts_hi << 32) | (unsigned)ts_lo) : 0ull;
        if (lane == 62) stamps[62] = rt_entry; if (lane == 63) stamps[63] = (unsigned long long)wall_clock64(); }
#undef PG8_STAMP
#undef PG8_SA
#undef PG8_SB
#undef PG8_STAGE
#undef PG8_SSPF
#undef PG8_LDA
#undef PG8_LDB
#undef PG8_MMA
#undef PG8_WAIT_V
#undef PG8_WAIT_L
#undef PG8_BAR
#undef PG8_SCHED
}
}

#ifndef PROBE_MASK
#define PROBE_MASK 0
#endif
#ifndef PROBE_N
#define PROBE_N 2
#endif
#ifndef PROBE_PART
#define PROBE_PART 0
#endif

using pg8::bf16_t; using pg8::f32x4; using pg8::u32x4; using pg8::cvt_pk_bf16; using pg8::bflo; using pg8::bfhi;
typedef unsigned u32x2 __attribute__((ext_vector_type(2)));
#define LAS __attribute__((address_space(3)))
constexpr int T = 49152, D = 1024, FF = 2816, NBATCH = 24, SEQ = 2048, NPROMPT = 32768;
constexpr int NWAVES = 8, NTHREADS = 512;
constexpr int LDS_BYTES = 147456;
constexpr size_t MiB = 1u << 20;
constexpr size_t WS_SS = 0;
constexpr size_t WS_RPB = 1536 * 1024;
constexpr size_t WS_BAR = 1792 * 1024;
constexpr size_t WS_HN = 2 * MiB;
constexpr size_t WS_FT = 10 * MiB;
constexpr size_t WS_WGU = 14 * MiB;
constexpr size_t WS_WD = 58 * MiB;
constexpr size_t WS_WIN = 80 * MiB;
constexpr size_t WS_WMO = 84 * MiB;
constexpr size_t WS_WQKV = 86 * MiB;
constexpr size_t WS_WO = 92 * MiB;
constexpr size_t WS_XB = 96 * MiB;
constexpr size_t WS_BIG = 192 * MiB;
constexpr size_t WS_END = 480 * MiB;
constexpr size_t BIG_Z = 192 * MiB, BIG_YT = 240 * MiB;
constexpr size_t OUT_MID = 0, OUT_X0 = 96 * MiB;

__device__ __forceinline__ float wave_sum(float v) {
#pragma unroll
    for (int o = 1; o < 64; o <<= 1) v += __shfl_xor(v, o);
    return v;
}
__device__ __forceinline__ float wave_max(float v) {
#pragma unroll
    for (int o = 1; o < 64; o <<= 1) v = fmaxf(v, __shfl_xor(v, o));
    return v;
}
__device__ __forceinline__ unsigned f2bf(float f) { unsigned u = __float_as_uint(f); return (u + 0x7fffu + ((u >> 16) & 1u)) >> 16; }
__device__ __forceinline__ float bf2f(bf16_t b) { return __uint_as_float((unsigned)b << 16); }
#define LDS_WAIT() asm volatile("s_waitcnt lgkmcnt(0)" ::: "memory")

#define XB_TMO      128
#define XB_XCNT(j)  (256  + 64 * (j))
#define XB_XSUB(j)  (1280 + 64 * (j))
#define XB_XGEN(j)  (2304 + 64 * (j))
#define XB_TOP      3328
#define XB_TOPGEN   3392
#define XCD_BAR_WORDS 3456
#define XB_SPIN_CAP (1u << 18)

__device__ __forceinline__ unsigned xb_ld(unsigned* p)              { return __hip_atomic_load(p, __ATOMIC_RELAXED, __HIP_MEMORY_SCOPE_AGENT); }
__device__ __forceinline__ unsigned xb_add(unsigned* p, unsigned v) { return __hip_atomic_fetch_add(p, v, __ATOMIC_RELAXED, __HIP_MEMORY_SCOPE_AGENT); }
__device__ __forceinline__ unsigned xb_xcc_id() { return (unsigned)__builtin_amdgcn_s_getreg((3 << 11) | 20) & 0xFu; }
#define XB_SPIN(cond, bar) do { unsigned _sp = 0; while (cond) { __builtin_amdgcn_s_sleep(1); \
    if ((++_sp & 255u) == 0u) { if (xb_ld(&(bar)[XB_TMO])) break; if (_sp > XB_SPIN_CAP) { atomicAdd(&(bar)[XB_TMO], 1u); break; } } } } while (0)

struct XcdBarrier {
    unsigned* bar; unsigned x;
    volatile LAS unsigned* st;
};

__device__ __forceinline__ XcdBarrier xcd_barrier_post(unsigned* bar, volatile LAS unsigned* st) {
    XcdBarrier b; b.bar = bar; b.x = xb_xcc_id(); b.st = st;
    if (threadIdx.x == 0) (void)xb_add(&bar[XB_XCNT(b.x)], 1u);
    return b;
}
__device__ __forceinline__ void xcd_barrier_complete(unsigned* bar, unsigned x, unsigned& nloc, unsigned& nx) {
    const unsigned G = gridDim.x * gridDim.y * gridDim.z;
    unsigned sum, cnt, mine, sp = 0u;
    for (;;) {
        sum = 0u; cnt = 0u; mine = 0u;
#pragma unroll
        for (unsigned j = 0; j < 16; ++j) { const unsigned c = xb_ld(&bar[XB_XCNT(j)]); sum += c; cnt += (c > 0u) ? 1u : 0u; mine = (j == x) ? c : mine; }
        if (sum == G) break;
        __builtin_amdgcn_s_sleep(1);
        if ((++sp & 255u) == 0u) { if (xb_ld(&bar[XB_TMO])) break; if (sp > XB_SPIN_CAP) { atomicAdd(&bar[XB_TMO], 1u); break; } }
    }
    nloc = mine > 0u ? mine : 1u; nx = cnt > 0u ? cnt : 1u;
}

__device__ __forceinline__ void xcd_barrier(const XcdBarrier& b) {
    asm volatile("s_waitcnt vmcnt(0)" ::: "memory");
    __syncthreads();
    if (threadIdx.x == 0) {
        unsigned* bar = b.bar;
        __builtin_amdgcn_s_waitcnt(0);
        unsigned nloc = b.st[0], nx = b.st[1];
        if (nloc == 0u) { xcd_barrier_complete(bar, b.x, nloc, nx); b.st[0] = nloc; b.st[1] = nx; }
        const unsigned old = xb_add(&bar[XB_XSUB(b.x)], 1u);
        const unsigned gen = old / nloc;
        if (old + 1u == (gen + 1u) * nloc) {
            __builtin_amdgcn_fence(__ATOMIC_RELEASE, "agent");
            asm volatile("s_waitcnt vmcnt(0)" ::: "memory");
            const unsigned og = xb_add(&bar[XB_TOP], 1u);
            const unsigned tg = og / nx;
            if (og + 1u == (tg + 1u) * nx) xb_add(&bar[XB_TOPGEN], 1u);
            else XB_SPIN(xb_ld(&bar[XB_TOPGEN]) == tg, bar);
            __builtin_amdgcn_fence(__ATOMIC_ACQUIRE, "agent");
            xb_add(&bar[XB_XGEN(b.x)], 1u);
            asm volatile("s_waitcnt vmcnt(0)" ::: "memory");
        } else {
            XB_SPIN(xb_ld(&bar[XB_XGEN(b.x)]) == gen, bar);
            __builtin_amdgcn_fence(__ATOMIC_ACQUIRE, "agent");
            asm volatile("s_waitcnt vmcnt(0)" ::: "memory");
        }
    }
    __syncthreads();
}


struct Args { const float* in[27]; float* out; unsigned char* ws; int ph_lo, ph_hi, rep_mask, rep_n; };
typedef const Args __attribute__((address_space(4)))* CArgsP;

__device__ __forceinline__ void transpose_item(const float* W, int N, const float* ks, bf16_t* WT, int ldd, int koff, int gu, int rowadd, LAS float* scr, int item, int lane) {
    const int nblk = N / 32, kb = item / nblk, nb = item % nblk, k0 = 64 * kb, n0 = 32 * nb;
    {
        const int r8 = lane >> 3, c4 = lane & 7;
        f32x4 wv[8];
#pragma unroll
        for (int i = 0; i < 8; ++i) wv[i] = *(const f32x4*)(W + (size_t)(k0 + 8 * i + r8) * N + n0 + 4 * c4);
#pragma unroll
        for (int i = 0; i < 8; ++i) { const int kk = 8 * i + r8; const float sc = ks ? ks[k0 + kk] : 1.0f; LAS float* d = scr + kk * 33 + 4 * c4;
            d[0] = wv[i][0] * sc; d[1] = wv[i][1] * sc; d[2] = wv[i][2] * sc; d[3] = wv[i][3] * sc; }
    }
    LDS_WAIT();
    const int c = lane & 7;
#pragma unroll
    for (int j = 0; j < 4; ++j) { const int n = (lane >> 3) + 8 * j; const LAS float* s = scr + (8 * c) * 33 + n;
        u32x4 o; o.x = cvt_pk_bf16(s[0 * 33], s[1 * 33]); o.y = cvt_pk_bf16(s[2 * 33], s[3 * 33]); o.z = cvt_pk_bf16(s[4 * 33], s[5 * 33]); o.w = cvt_pk_bf16(s[6 * 33], s[7 * 33]);
        const int nn = n0 + n; const int row = gu ? (256 * (nn >> 7) + (nn & 127) + rowadd) : (nn + rowadd);
        *(u32x4*)(WT + (size_t)row * ldd + koff + k0 + 8 * c) = o; }
    LDS_WAIT();
}
__device__ __forceinline__ void conv_matrix(const float* W, int K, int N, const float* ks, bf16_t* WT, int ldd, int koff, int gu, int rowadd, LAS float* scr, int gw, int NGW, int lane, int& off) {
    const int nitems = (K / 64) * (N / 32);
    int it0 = (gw - off) % NGW; if (it0 < 0) it0 += NGW;
    for (int it = it0; it < nitems; it += NGW) transpose_item(W, N, ks, WT, ldd, koff, gu, rowadd, scr, it, lane);
    off = (off + nitems) % NGW;
}

__device__ __forceinline__ void p0_prologue(CArgsP a, LAS unsigned char* lds, int tid, int lane, int wave, int G) {
    unsigned char* ws = a->ws;
    const int gw = blockIdx.x * NWAVES + wave, NGW = G * NWAVES;
    const int gtid = blockIdx.x * NTHREADS + tid, GT = G * NTHREADS;
    float* SS = (float*)(ws + WS_SS);
    for (int i = gtid; i < 5 * T; i += GT) SS[T + i] = 0.f;
    {
        const float* rpb = a->in[25]; float* rpp = (float*)(ws + WS_RPB);
        for (int i = gtid; i < 16 * 15 * 64; i += GT) { const int dc = (i & 63) - 16; rpp[i] = (dc >= 0 && dc < 31) ? rpb[(i >> 6) * 31 + dc] * 1.4426950408889634f : 0.f; }
    }
    for (int rp_ = 0; rp_ < (PROBE_PART == 1 ? 5 : 1); ++rp_) {
        bf16_t* XB = (bf16_t*)(ws + WS_XB);
        for (int m0 = gw; m0 < T; m0 += 2 * NGW) {
            const int m1 = m0 + NGW; const bool has1 = m1 < T;
            const float* xr0 = (m0 < NPROMPT) ? a->in[0] + (size_t)m0 * D : a->in[1] + (size_t)(m0 - NPROMPT) * D;
            const float* xr1 = has1 ? ((m1 < NPROMPT) ? a->in[0] + (size_t)m1 * D : a->in[1] + (size_t)(m1 - NPROMPT) * D) : xr0;
            f32x4 v[4], w[4]; float s = 0.f, s1 = 0.f;
#pragma unroll
            for (int j = 0; j < 4; ++j) { v[j] = ((const f32x4*)xr0)[64 * j + lane]; w[j] = ((const f32x4*)xr1)[64 * j + lane]; }
#pragma unroll
            for (int j = 0; j < 4; ++j) { s += (v[j].x * v[j].x + v[j].y * v[j].y) + (v[j].z * v[j].z + v[j].w * v[j].w); s1 += (w[j].x * w[j].x + w[j].y * w[j].y) + (w[j].z * w[j].z + w[j].w * w[j].w); }
            s = wave_sum(s); s1 = wave_sum(s1);
#pragma unroll
            for (int j = 0; j < 4; ++j) { u32x2 o; o.x = cvt_pk_bf16(v[j].x, v[j].y); o.y = cvt_pk_bf16(v[j].z, v[j].w); ((u32x2*)(XB + (size_t)m0 * D))[64 * j + lane] = o; }
            if (lane == 0) SS[m0] = s;
            if (has1) {
#pragma unroll
                for (int j = 0; j < 4; ++j) { u32x2 o; o.x = cvt_pk_bf16(w[j].x, w[j].y); o.y = cvt_pk_bf16(w[j].z, w[j].w); ((u32x2*)(XB + (size_t)m1 * D))[64 * j + lane] = o; }
                if (lane == 0) SS[m1] = s1;
            }
        }
    }
    for (int rp_ = 0; rp_ < (PROBE_PART == 2 ? 5 : 1); ++rp_) {
        LAS float* scr = (LAS float*)(lds + wave * 16384);
        int off = 0;
        const float* ng = a->in[2];
        for (int f = 0; f < 4; ++f) {
            const int layer = f >> 1, j = f & 1;
            const float* gain = ng + (size_t)(layer * 3 + (j ? 2 : 0)) * D;
            bf16_t* wgu = (bf16_t*)(ws + WS_WGU) + (size_t)f * 5632 * 1024;
            bf16_t* wd = (bf16_t*)(ws + WS_WD) + (size_t)f * 1024 * 2816;
            conv_matrix(a->in[3] + (size_t)f * D * FF, D, FF, gain, wgu, D, 0, 1, 0, scr, gw, NGW, lane, off);
            conv_matrix(a->in[4] + (size_t)f * D * FF, D, FF, gain, wgu, D, 0, 1, 128, scr, gw, NGW, lane, off);
            conv_matrix(a->in[5] + (size_t)f * FF * D, FF, D, nullptr, wd, FF, 0, 0, 0, scr, gw, NGW, lane, off);
        }
        conv_matrix(a->in[6], D, 2048, ng + 1 * D, (bf16_t*)(ws + WS_WIN), D, 0, 0, 0, scr, gw, NGW, lane, off);
        conv_matrix(a->in[22], D, 3072, ng + 4 * D, (bf16_t*)(ws + WS_WQKV), D, 0, 0, 0, scr, gw, NGW, lane, off);
        conv_matrix(a->in[26], D, D, nullptr, (bf16_t*)(ws + WS_WO), D, 0, 0, 0, scr, gw, NGW, lane, off);
        conv_matrix(a->in[21] + (size_t)512 * D, 512, D, nullptr, (bf16_t*)(ws + WS_WMO), D, 512, 0, 0, scr, gw, NGW, lane, off);
    }
    for (int rp_ = 0; rp_ < (PROBE_PART == 3 ? 5 : 1); ++rp_) {
        const float* pw = a->in[7]; const float* psc = a->in[8]; const float* wout = a->in[21];
        bf16_t* wmo = (bf16_t*)(ws + WS_WMO);
        for (int item = gw; item < 512 * 16; item += NGW) {
            const int k = item >> 4, nb = item & 15, g = k >> 7, n = nb * 64 + lane;
            const float pa = pw[(size_t)k * 128 + lane] * psc[g * 128 + lane], pb = pw[(size_t)k * 128 + 64 + lane] * psc[g * 128 + 64 + lane];
            const float* wr = wout + (size_t)(g * 128) * D + n;
            float s = 0.f;
#pragma unroll 16
            for (int d = 0; d < 64; ++d) s += __shfl(pa, d) * wr[(size_t)d * D];
#pragma unroll 16
            for (int d = 0; d < 64; ++d) s += __shfl(pb, d) * wr[(size_t)(64 + d) * D];
            wmo[(size_t)n * D + k] = (bf16_t)f2bf(s);
        }
    }
    for (int rp_ = 0; rp_ < (PROBE_PART == 4 ? 5 : 1); ++rp_) {
        const float *w1 = a->in[11], *b1 = a->in[12], *w2 = a->in[13], *b2 = a->in[14], *w3 = a->in[15], *b3 = a->in[16], *freq = a->in[17], *wo = a->in[18], *deltas = a->in[19], *hbias = a->in[20];
        bf16_t* FT = (bf16_t*)(ws + WS_FT);
        for (int t = gw; t < SEQ; t += NGW) {
            const float tn = (float)t / 2047.0f;
            float zval = 0.f;
            if (lane == 0) zval = tn;
            else if (lane <= 32) {
                const int bi = (lane - 1) & 15;
                const float band = 1e-4f + (float)bi * ((15.0f - 1e-4f) / 15.0f);
                const float ang = (6.283185307179586f / 2048.0f) * (float)t * band;
                zval = (lane <= 16) ? cosf(ang) : -sinf(ang);
            }
            const float fr = freq[lane];
            const float bb1 = b1[lane], bb2 = b2[lane], bb3 = b3[lane];
            float pre = bb1, h;
#pragma unroll
            for (int ic = 0; ic < 2; ++ic) {
                const float* wp = w1 + ic * 16 * 64 + lane; asm volatile("" : "+v"(wp));
                float wc[16];
#pragma unroll
                for (int i = 0; i < 16; ++i) wc[i] = wp[i * 64];
                __builtin_amdgcn_sched_barrier(0);
#pragma unroll
                for (int i = 0; i < 16; ++i) pre += __shfl(zval, ic * 16 + i) * wc[i];
                __builtin_amdgcn_sched_barrier(0);
            }
            pre += __shfl(zval, 32) * w1[32 * 64 + lane];
            h = sinf(fr * pre);
            pre = bb2;
#pragma unroll
            for (int ic = 0; ic < 4; ++ic) {
                const float* wp = w2 + ic * 16 * 64 + lane; asm volatile("" : "+v"(wp));
                float wc[16];
#pragma unroll
                for (int i = 0; i < 16; ++i) wc[i] = wp[i * 64];
                __builtin_amdgcn_sched_barrier(0);
#pragma unroll
                for (int i = 0; i < 16; ++i) pre += __shfl(h, ic * 16 + i) * wc[i];
                __builtin_amdgcn_sched_barrier(0);
            }
            h = sinf(fr * pre);
            pre = bb3;
#pragma unroll
            for (int ic = 0; ic < 4; ++ic) {
                const float* wp = w3 + ic * 16 * 64 + lane; asm volatile("" : "+v"(wp));
                float wc[16];
#pragma unroll
                for (int i = 0; i < 16; ++i) wc[i] = wp[i * 64];
                __builtin_amdgcn_sched_barrier(0);
#pragma unroll
                for (int i = 0; i < 16; ++i) pre += __shfl(h, ic * 16 + i) * wc[i];
                __builtin_amdgcn_sched_barrier(0);
            }
            h = sinf(fr * pre);
            float o[16];
#pragma unroll
            for (int q = 0; q < 16; ++q) o[q] = 0.f;
#pragma unroll 1
            for (int ib = 0; ib < 16; ++ib) {
                float wv[4][16];
#pragma unroll
                for (int ii = 0; ii < 4; ++ii) {
                    const float* wp = wo + (ib * 4 + ii) * 1024 + lane; asm volatile("" : "+v"(wp));
#pragma unroll
                    for (int q = 0; q < 16; ++q) wv[ii][q] = wp[64 * q];
                }
                __builtin_amdgcn_sched_barrier(0);
#pragma unroll
                for (int ii = 0; ii < 4; ++ii) { const float hv = __shfl(h, ib * 4 + ii);
#pragma unroll
                    for (int q = 0; q < 16; ++q) o[q] += hv * wv[ii][q]; }
                __builtin_amdgcn_sched_barrier(0);
            }
#pragma unroll
            for (int q = 0; q < 16; ++q) {
                const int c2 = lane + 64 * q;
                const float val = o[q] * (__expf(-tn * fabsf(deltas[c2])) + 0.05f);
                const int dir = c2 >> 9, c = c2 & 511;
                if (dir == 0) FT[(size_t)c * 4096 + 2048 - t] = (bf16_t)f2bf(t ? val : val + hbias[c]);
                else FT[(size_t)c * 4096 + (t ? 2048 + t : 0)] = (bf16_t)(t ? f2bf(val) : 0u);
            }
        }
    }
}

__device__ __forceinline__ void sc_load(const bf16_t* P, int tile, int li, int cj, u32x4 (&v)[3][3]) {
    const int ct = tile & 7, lt = (tile >> 3) & 31, b = tile >> 8;
    const int l = lt * 64 + li, c = ct * 64 + cj * 8; const size_t t = (size_t)b * SEQ + l;
    const u32x4 zero = (u32x4){0u, 0u, 0u, 0u};
#pragma unroll
    for (int sg = 0; sg < 3; ++sg) {
        const bf16_t* pc = P + t * 2048 + 512 + sg * 512 + c;
        v[sg][0] = (l > 0) ? *(const u32x4*)(pc - 2048) : zero;
        v[sg][1] = *(const u32x4*)pc;
        v[sg][2] = (l < SEQ - 1) ? *(const u32x4*)(pc + 2048) : zero;
    }
}
__device__ __forceinline__ void elt0_phase(CArgsP a, LAS unsigned char* lds, int tid, int G) {
    const int gtid = blockIdx.x * NTHREADS + tid, GT = G * NTHREADS;
    const bf16_t* P = (const bf16_t*)(a->ws + WS_BIG);
    bf16_t* MIDp = (bf16_t*)((unsigned char*)a->out + OUT_MID);
    bf16_t* X0 = (bf16_t*)((unsigned char*)a->out + OUT_X0);
    bf16_t* ZT = (bf16_t*)(a->ws + WS_BIG + BIG_Z);
    const float* sw = a->in[9]; const float* sb = a->in[10];
    for (int idx = gtid; idx < T * 64; idx += GT) {
        const int c8 = idx & 63, t = idx >> 6, l = t & (SEQ - 1), c = c8 * 8;
        const int g = c8 >> 4, hw = 1 << g;
        const bf16_t* base = P + (size_t)t * 2048 + c;
        u32x4 rv[16];
        int cnt = 0;
#pragma unroll
        for (int q = -8; q < 8; ++q) {
            const int pos = l + q;
            const bool ok = (q >= -hw) && (q < hw) && (pos >= 0) && (pos < SEQ);
            rv[q + 8] = (u32x4){0u, 0u, 0u, 0u};
            if (ok) { rv[q + 8] = *(const u32x4*)(base + (ptrdiff_t)q * 2048); ++cnt; }
        }
        float s[8];
#pragma unroll
        for (int j = 0; j < 8; ++j) s[j] = 0.f;
#pragma unroll
        for (int q = 0; q < 16; ++q) { const u32x4 v = rv[q];
            s[0] += bflo(v.x); s[1] += bfhi(v.x); s[2] += bflo(v.y); s[3] += bfhi(v.y); s[4] += bflo(v.z); s[5] += bfhi(v.z); s[6] += bflo(v.w); s[7] += bfhi(v.w); }
        const float inv = 1.0f / (float)cnt;
        const u32x4 uu = rv[8];
        u32x4 o;
        o.x = cvt_pk_bf16(s[0] * inv - bflo(uu.x), s[1] * inv - bfhi(uu.x)); o.y = cvt_pk_bf16(s[2] * inv - bflo(uu.y), s[3] * inv - bfhi(uu.y));
        o.z = cvt_pk_bf16(s[4] * inv - bflo(uu.z), s[5] * inv - bfhi(uu.z)); o.w = cvt_pk_bf16(s[6] * inv - bflo(uu.w), s[7] * inv - bfhi(uu.w));
        *(u32x4*)(MIDp + (size_t)t * 1024 + c) = o;
    }
    LAS bf16_t* zt = (LAS bf16_t*)lds;
    const int li = tid >> 3, cj = tid & 7;
    constexpr int NT = NBATCH * 32 * 8;
    u32x4 vb[3][3];
    if ((int)blockIdx.x < NT) sc_load(P, blockIdx.x, li, cj, vb);
    for (int tile = blockIdx.x; tile < NT; tile += G) {
        u32x4 vn[3][3];
#pragma unroll
        for (int x = 0; x < 3; ++x)
#pragma unroll
            for (int y = 0; y < 3; ++y) vn[x][y] = (u32x4){0u, 0u, 0u, 0u};
        if (tile + G < NT) sc_load(P, tile + G, li, cj, vn);
        const int ct = tile & 7, lt = (tile >> 3) & 31, b = tile >> 8;
        const int l = lt * 64 + li, c = ct * 64 + cj * 8; const size_t t = (size_t)b * SEQ + l;
        float r[3][8];
#pragma unroll
        for (int sg = 0; sg < 3; ++sg) {
            const int cc = sg * 512 + c;
            const u32x4 vm = vb[sg][0], v0 = vb[sg][1], vp = vb[sg][2];
            const f32x4 wa0 = *(const f32x4*)(sw + cc), wa1 = *(const f32x4*)(sw + cc + 4);
            const f32x4 wb0 = *(const f32x4*)(sw + 1536 + cc), wb1 = *(const f32x4*)(sw + 1536 + cc + 4);
            const f32x4 wc0 = *(const f32x4*)(sw + 3072 + cc), wc1 = *(const f32x4*)(sw + 3072 + cc + 4);
            const f32x4 bb0 = *(const f32x4*)(sb + cc), bb1 = *(const f32x4*)(sb + cc + 4);
            r[sg][0] = bflo(vm.x) * wa0[0] + bflo(v0.x) * wb0[0] + bflo(vp.x) * wc0[0] + bb0[0];
            r[sg][1] = bfhi(vm.x) * wa0[1] + bfhi(v0.x) * wb0[1] + bfhi(vp.x) * wc0[1] + bb0[1];
            r[sg][2] = bflo(vm.y) * wa0[2] + bflo(v0.y) * wb0[2] + bflo(vp.y) * wc0[2] + bb0[2];
            r[sg][3] = bfhi(vm.y) * wa0[3] + bfhi(v0.y) * wb0[3] + bfhi(vp.y) * wc0[3] + bb0[3];
            r[sg][4] = bflo(vm.z) * wa1[0] + bflo(v0.z) * wb1[0] + bflo(vp.z) * wc1[0] + bb1[0];
            r[sg][5] = bfhi(vm.z) * wa1[1] + bfhi(v0.z) * wb1[1] + bfhi(vp.z) * wc1[1] + bb1[1];
            r[sg][6] = bflo(vm.w) * wa1[2] + bflo(v0.w) * wb1[2] + bflo(vp.w) * wc1[2] + bb1[2];
            r[sg][7] = bfhi(vm.w) * wa1[3] + bfhi(v0.w) * wb1[3] + bfhi(vp.w) * wc1[3] + bb1[3];
        }
        u32x4 ox;
        ox.x = cvt_pk_bf16(r[0][0], r[0][1]); ox.y = cvt_pk_bf16(r[0][2], r[0][3]); ox.z = cvt_pk_bf16(r[0][4], r[0][5]); ox.w = cvt_pk_bf16(r[0][6], r[0][7]);
        *(u32x4*)(X0 + t * 512 + c) = ox;
#pragma unroll
        for (int j = 0; j < 8; ++j) zt[(cj * 8 + j) * 72 + li] = (bf16_t)f2bf(r[2][j] * r[1][j]);
        __syncthreads();
        {
            const int cr = tid >> 3, ch = tid & 7;
            const u32x4 v = *(const LAS u32x4*)(zt + cr * 72 + ch * 8);
            *(u32x4*)(ZT + ((size_t)(ct * 64 + cr) * NBATCH + b) * SEQ + lt * 64 + ch * 8) = v;
        }
        __syncthreads();
#pragma unroll
        for (int x = 0; x < 3; ++x)
#pragma unroll
            for (int y = 0; y < 3; ++y) vb[x][y] = vn[x][y];
    }
}

typedef float f32x16 __attribute__((ext_vector_type(16)));
typedef short bf16x8 __attribute__((ext_vector_type(8)));
__device__ __forceinline__ void conv_phase(CArgsP a, LAS unsigned char* lds, int tid, int lane, int wave, int G) {
    constexpr int ZSTR = 4112, FSTR = 8256  , F_OFF = NBATCH * ZSTR;
    const bf16_t* FT = (const bf16_t*)(a->ws + WS_FT);
    const bf16_t* ZT = (const bf16_t*)(a->ws + WS_BIG + BIG_Z);
    bf16_t* YT = (bf16_t*)(a->ws + WS_BIG + BIG_YT);
    const int r = lane & 31, h = lane >> 5, q = (-r) & 3;
    const int brow = r < NBATCH ? r : r - 8;
    for (int c = blockIdx.x; c < 512; c += G) {
        __syncthreads();
        {
            const u32x4 v = *(const u32x4*)(FT + (size_t)c * 4096 + tid * 8);
            *(LAS u32x4*)(lds + F_OFF + tid * 16) = v;
            const unsigned wv[4] = {v.x, v.y, v.z, v.w};
#pragma unroll
            for (int qq = 1; qq < 4; ++qq)
#pragma unroll
                for (int j = 0; j < 8; ++j) {
                    const int pos = tid * 8 + j - qq;
                    const bf16_t e = (bf16_t)((j & 1) ? (wv[j >> 1] >> 16) : (wv[j >> 1] & 0xffffu));
                    if (pos >= 0) *(LAS bf16_t*)(lds + F_OFF + qq * FSTR + pos * 2) = e;
                }
        }
#pragma unroll
        for (int i = 0; i < 12; ++i) {
            const int id = tid + 512 * i, row = id >> 8, col = id & 255;
            const u32x4 v = *(const u32x4*)(ZT + ((size_t)c * NBATCH + row) * SEQ + col * 8);
            *(LAS u32x4*)(lds + row * ZSTR + col * 16) = v;
        }
        __syncthreads();
#pragma unroll 1
        for (int gI = 0; gI < 2; ++gI) {
            const int t0 = (wave * 8 + gI * 4) * 32;
            f32x16 acc[4];
#pragma unroll
            for (int i = 0; i < 4; ++i)
#pragma unroll
                for (int e = 0; e < 16; ++e) acc[i][e] = 0.f;
            int boff = brow * ZSTR + 16 * h;
            int aoff = F_OFF + q * FSTR + (2048 - r + 8 * h - q - t0) * 2;
#define DSR64(dst, addr, OFF) asm volatile("ds_read_b64 %0, %1 offset:" #OFF : "=v"(dst) : "v"(addr))
#define DSR128(dst, addr, OFF) asm volatile("ds_read_b128 %0, %1 offset:" #OFF : "=v"(dst) : "v"(addr))
#define CV_H0(B, L0, H0, L1, H1, SB, S0, S0H, S1, S1H) do { DSR128(B, rb, SB); DSR64(L0, ra, S0); DSR64(H0, ra, S0H); DSR64(L1, ra, S1); DSR64(H1, ra, S1H); } while (0)
#define CV_H1(L2, H2, L3, H3, S2, S2H, S3, S3H) do { DSR64(L2, ra, S2); DSR64(H2, ra, S2H); DSR64(L3, ra, S3); DSR64(H3, ra, S3H); } while (0)
#define CV_WAIT5(N, B, L0, H0, L1, H1) asm volatile("s_waitcnt lgkmcnt(" #N ")" : "+v"(B), "+v"(L0), "+v"(H0), "+v"(L1), "+v"(H1))
#define CV_WAIT4(N, L2, H2, L3, H3) asm volatile("s_waitcnt lgkmcnt(" #N ")" : "+v"(L2), "+v"(H2), "+v"(L3), "+v"(H3))
#define CV_MM(B, L, H, j) acc[j] = __builtin_amdgcn_mfma_f32_32x32x16_bf16(__builtin_bit_cast(bf16x8, B), __builtin_bit_cast(bf16x8, ((u32x4){L.x, L.y, H.x, H.y})), acc[j], 0, 0, 0)
            unsigned rb = (unsigned)(__UINTPTR_TYPE__)lds + (unsigned)boff;
            unsigned ra = (unsigned)(__UINTPTR_TYPE__)lds + (unsigned)(aoff - 192);
            u32x4 bP, bQ; u32x2 l0P, h0P, l1P, h1P, l0Q, h0Q, l1Q, h1Q, l2, h2, l3, h3, l2b, h2b, l3b, h3b;
            CV_H0(bP, l0P, h0P, l1P, h1P, 0, 192, 200, 128, 136);
#pragma unroll 1
            for (int s0 = 0; s0 < SEQ; s0 += 32) {
                CV_H1(l2, h2, l3, h3, 64, 72, 0, 8);
                CV_WAIT5(4, bP, l0P, h0P, l1P, h1P);
                CV_MM(bP, l0P, h0P, 0); CV_MM(bP, l1P, h1P, 1);
                CV_H0(bQ, l0Q, h0Q, l1Q, h1Q, 32, 224, 232, 160, 168);
                CV_WAIT4(5, l2, h2, l3, h3);
                CV_MM(bP, l2, h2, 2); CV_MM(bP, l3, h3, 3);
                CV_H1(l2b, h2b, l3b, h3b, 96, 104, 32, 40);
                CV_WAIT5(4, bQ, l0Q, h0Q, l1Q, h1Q);
                CV_MM(bQ, l0Q, h0Q, 0); CV_MM(bQ, l1Q, h1Q, 1);
                rb += 64; ra += 64;
                CV_H0(bP, l0P, h0P, l1P, h1P, 0, 192, 200, 128, 136);
                CV_WAIT4(5, l2b, h2b, l3b, h3b);
                CV_MM(bQ, l2b, h2b, 2); CV_MM(bQ, l3b, h3b, 3);
            }
            asm volatile("s_waitcnt lgkmcnt(0)" ::: "memory");
#undef DSR64
#undef DSR128
#undef CV_H0
#undef CV_H1
#undef CV_WAIT5
#undef CV_WAIT4
#undef CV_MM
#pragma unroll
            for (int i = 0; i < 4; ++i) {
                const int t = t0 + i * 32 + r;
                bf16_t* yp = YT + ((size_t)c * NBATCH + 4 * h) * SEQ + t;
                asm volatile("" : "+v"(yp));
#pragma unroll
                for (int e = 0; e < 12; ++e) {
                    const int bb0 = (e & 3) + 8 * (e >> 2);
                    yp[(size_t)bb0 * SEQ] = (bf16_t)f2bf(acc[i][e]);
                }
            }
        }
    }
}

__device__ __forceinline__ void trn_load(const bf16_t* YT, const bf16_t* X0, int tile, int tid, u32x4& yv, u32x4& xv) {
    const int ct = tile & 7, lt = (tile >> 3) & 31, b = tile >> 8;
    const int cr = tid >> 3, ch = tid & 7;
    yv = *(const u32x4*)(YT + ((size_t)(ct * 64 + cr) * NBATCH + b) * SEQ + lt * 64 + ch * 8);
    xv = *(const u32x4*)(X0 + ((size_t)b * SEQ + lt * 64 + cr) * 512 + ct * 64 + ch * 8);
}
__device__ __forceinline__ void trn_phase(CArgsP a, LAS unsigned char* lds, int tid, int G) {
    const bf16_t* YT = (const bf16_t*)(a->ws + WS_BIG + BIG_YT);
    const bf16_t* X0 = (const bf16_t*)((unsigned char*)a->out + OUT_X0);
    bf16_t* MIDp = (bf16_t*)((unsigned char*)a->out + OUT_MID);
    LAS bf16_t* zt = (LAS bf16_t*)lds;
    const int li = tid >> 3, cj = tid & 7;
    constexpr int NT = NBATCH * 32 * 8;
    u32x4 yv = (u32x4){0u, 0u, 0u, 0u}, xv = yv;
    if ((int)blockIdx.x < NT) trn_load(YT, X0, blockIdx.x, tid, yv, xv);
    for (int tile = blockIdx.x; tile < NT; tile += G) {
        u32x4 yn = (u32x4){0u, 0u, 0u, 0u}, xn = yn;
        if (tile + G < NT) trn_load(YT, X0, tile + G, tid, yn, xn);
        const int ct = tile & 7, lt = (tile >> 3) & 31, b = tile >> 8;
        *(LAS u32x4*)(zt + li * 72 + cj * 8) = yv;
        __syncthreads();
        const int l = lt * 64 + li, c = ct * 64 + cj * 8; const size_t t = (size_t)b * SEQ + l;
        float y[8];
#pragma unroll
        for (int j = 0; j < 8; ++j) y[j] = bf2f(zt[(cj * 8 + j) * 72 + li]);
        u32x4 o;
        o.x = cvt_pk_bf16(y[0] * bflo(xv.x), y[1] * bfhi(xv.x)); o.y = cvt_pk_bf16(y[2] * bflo(xv.y), y[3] * bfhi(xv.y));
        o.z = cvt_pk_bf16(y[4] * bflo(xv.z), y[5] * bfhi(xv.z)); o.w = cvt_pk_bf16(y[6] * bflo(xv.w), y[7] * bfhi(xv.w));
        *(u32x4*)(MIDp + t * 1024 + 512 + c) = o;
        __syncthreads();
        yv = yn; xv = xn;
    }
}

__device__ __forceinline__ void qkn_phase(CArgsP a, LAS unsigned char* lds, int tid, int G) {
    bf16_t* QKV = (bf16_t*)(a->ws + WS_BIG);
    bf16_t* VT = (bf16_t*)((unsigned char*)a->out + OUT_X0);
    bf16_t* KH = (bf16_t*)((unsigned char*)a->out + OUT_MID);
    const float* gk = a->in[24];
    LAS bf16_t* zt = (LAS bf16_t*)lds;
    const int li = tid >> 3, cj = tid & 7;
    const f32x4 gk0 = *(const f32x4*)(gk + cj * 8), gk1 = *(const f32x4*)(gk + cj * 8 + 4);
    constexpr int NT = NBATCH * 32 * 16;
    u32x4 kv = (u32x4){0u, 0u, 0u, 0u}, vv = kv;
    if ((int)blockIdx.x < NT) { const int tile = blockIdx.x; const int h = tile & 15, lt = (tile >> 4) & 31, b = tile >> 9;
        const bf16_t* qp0 = QKV + ((size_t)b * SEQ + lt * 64 + li) * 3072 + h * 64 + cj * 8;
        kv = *(const u32x4*)(qp0 + 1024); vv = *(const u32x4*)(qp0 + 2048); }
    for (int tile = blockIdx.x; tile < NT; tile += G) {
        u32x4 kn = (u32x4){0u, 0u, 0u, 0u}, vn = kn;
        if (tile + G < NT) { const int tl = tile + G; const int h2 = tl & 15, lt2 = (tl >> 4) & 31, b2 = tl >> 9;
            const bf16_t* qp1 = QKV + ((size_t)b2 * SEQ + lt2 * 64 + li) * 3072 + h2 * 64 + cj * 8;
            kn = *(const u32x4*)(qp1 + 1024); vn = *(const u32x4*)(qp1 + 2048); }
        const int h = tile & 15, lt = (tile >> 4) & 31, b = tile >> 9;
        const size_t t = (size_t)b * SEQ + lt * 64 + li;
        bf16_t* qp = QKV + t * 3072 + h * 64 + cj * 8;
        float kf[8] = {bflo(kv.x), bfhi(kv.x), bflo(kv.y), bfhi(kv.y), bflo(kv.z), bfhi(kv.z), bflo(kv.w), bfhi(kv.w)};
        float sk = 0.f;
#pragma unroll
        for (int j = 0; j < 8; ++j) sk += kf[j] * kf[j];
        sk += __shfl_xor(sk, 1); sk += __shfl_xor(sk, 2); sk += __shfl_xor(sk, 4);
        const float rk = rsqrtf(sk * (1.0f / 64.0f) + 1e-6f);
        u32x4 ko;
        ko.x = cvt_pk_bf16(kf[0] * rk * gk0[0], kf[1] * rk * gk0[1]); ko.y = cvt_pk_bf16(kf[2] * rk * gk0[2], kf[3] * rk * gk0[3]);
        ko.z = cvt_pk_bf16(kf[4] * rk * gk1[0], kf[5] * rk * gk1[1]); ko.w = cvt_pk_bf16(kf[6] * rk * gk1[2], kf[7] * rk * gk1[3]);
        *(u32x4*)(KH + ((size_t)((b * 16 + h) * 32 + lt) * 8 + cj) * 512 + li * 8) = ko;
        const unsigned vw[4] = {vv.x, vv.y, vv.z, vv.w};
#pragma unroll
        for (int j = 0; j < 8; ++j) zt[(cj * 8 + j) * 72 + li] = (bf16_t)((j & 1) ? (vw[j >> 1] >> 16) : (vw[j >> 1] & 0xffffu));
        __syncthreads();
        {
            const int cr = tid >> 3, ch = tid & 7;
            const u32x4 v = *(const LAS u32x4*)(zt + cr * 72 + ch * 8);
            *(u32x4*)(VT + ((size_t)((b * 16 + h) * 32 + lt) * 8 + ch) * 512 + cr * 8) = v;
        }
        __syncthreads();
        kv = kn; vv = vn;
    }
}

__device__ __forceinline__ void attn_phase(CArgsP a, LAS unsigned char* lds, int tid, int lane, int wave, int G) {
    const int vcu = (G % 8 == 0) ? ((int)blockIdx.x % 8) * (G / 8) + (int)blockIdx.x / 8 : (int)blockIdx.x;
    const int gw = vcu * NWAVES + wave, NGW = G * NWAVES;
    const bf16_t* QKV = (const bf16_t*)(a->ws + WS_BIG);
    const bf16_t* VT = (const bf16_t*)((unsigned char*)a->out + OUT_X0);
    const bf16_t* KH = (const bf16_t*)((unsigned char*)a->out + OUT_MID);
    bf16_t* OQ = (bf16_t*)(a->ws + WS_BIG) + 1024;
    {
        const f32x4* src = (const f32x4*)(a->ws + WS_RPB);
        for (int i = tid; i < 16 * 15 * 64 / 4; i += NTHREADS) ((LAS f32x4*)lds)[i] = src[i];
        __syncthreads();
    }
    const volatile LAS float* rpl = (const volatile LAS float*)lds;
    LAS unsigned char* ost = lds + 61440 + wave * 2304;
    const int q16 = lane & 15, g = lane >> 4;
    const int keymap0 = 8 * (q16 >> 2) + (q16 & 3);
    const float* gqp = a->in[23] + 8 * g;
    for (int unit = gw; unit < NBATCH * 16 * 32 * 4; unit += NGW) {
        const int w = unit & 3, r = (unit >> 2) & 31, h = (unit >> 7) & 15, b = unit >> 11;
        int s0 = r - 4; s0 = s0 < 0 ? 0 : (s0 > 24 ? 24 : s0);
        int kc0 = 16 * w - 8; kc0 = kc0 < 0 ? 0 : (kc0 > 32 ? 32 : kc0);
        const int cq = 16 * w + q16;
        int cs = cq - 8; cs = cs < 0 ? 0 : (cs > 48 ? 48 : cs);
        const size_t tq = (size_t)b * SEQ + r * 64 + cq;
        const bf16_t* qp = QKV + tq * 3072 + h * 64 + 8 * g;
        const bf16_t* kbase = KH + ((size_t)((b * 16 + h) * 32 + s0) * 8 + g) * 512 + (kc0 + keymap0) * 8;
        const bf16_t* vbase = VT + ((size_t)((b * 16 + h) * 32 + s0) * 8 + (kc0 >> 3) + g) * 512 + q16 * 8;
        const volatile LAS float* bbase = rpl + (h * 15 + (s0 - r + 7)) * 64 + (kc0 + 8 * g - cq + 15 + 16);
        const u32x4 q0 = *(const u32x4*)qp, q1 = *(const u32x4*)(qp + 32);
        const f32x4 gqa0 = *(const f32x4*)gqp, gqa1 = *(const f32x4*)(gqp + 4), gqb0 = *(const f32x4*)(gqp + 32), gqb1 = *(const f32x4*)(gqp + 36);
        bf16x8 kf[8][2][2];
#pragma unroll
        for (int i = 0; i < 8; ++i)
#pragma unroll
            for (int tl = 0; tl < 2; ++tl) {
                const bf16_t* kp = kbase + i * 4096 + tl * 32;
                kf[i][tl][0] = *(const bf16x8*)kp; kf[i][tl][1] = *(const bf16x8*)(kp + 2048);
            }
        __builtin_amdgcn_sched_barrier(0);
        bf16x8 qf0, qf1;
        {
            float qa[8] = {bflo(q0.x), bfhi(q0.x), bflo(q0.y), bfhi(q0.y), bflo(q0.z), bfhi(q0.z), bflo(q0.w), bfhi(q0.w)};
            float qb[8] = {bflo(q1.x), bfhi(q1.x), bflo(q1.y), bfhi(q1.y), bflo(q1.z), bfhi(q1.z), bflo(q1.w), bfhi(q1.w)};
            float sq = 0.f;
#pragma unroll
            for (int j = 0; j < 8; ++j) sq += qa[j] * qa[j] + qb[j] * qb[j];
            sq += __shfl_xor(sq, 16); sq += __shfl_xor(sq, 32);
            const float rq = rsqrtf(sq * (1.0f / 64.0f) + 1e-6f) * (0.125f * 1.4426950408889634f);
            const u32x4 n0 = (u32x4){cvt_pk_bf16(qa[0] * rq * gqa0[0], qa[1] * rq * gqa0[1]), cvt_pk_bf16(qa[2] * rq * gqa0[2], qa[3] * rq * gqa0[3]),
                                     cvt_pk_bf16(qa[4] * rq * gqa1[0], qa[5] * rq * gqa1[1]), cvt_pk_bf16(qa[6] * rq * gqa1[2], qa[7] * rq * gqa1[3])};
            const u32x4 n1 = (u32x4){cvt_pk_bf16(qb[0] * rq * gqb0[0], qb[1] * rq * gqb0[1]), cvt_pk_bf16(qb[2] * rq * gqb0[2], qb[3] * rq * gqb0[3]),
                                     cvt_pk_bf16(qb[4] * rq * gqb1[0], qb[5] * rq * gqb1[1]), cvt_pk_bf16(qb[6] * rq * gqb1[2], qb[7] * rq * gqb1[3])};
            qf0 = __builtin_bit_cast(bf16x8, n0); qf1 = __builtin_bit_cast(bf16x8, n1);
        }
        __builtin_amdgcn_sched_barrier(0);
        f32x4 sT[8][2];
#pragma unroll
        for (int i = 0; i < 8; ++i)
#pragma unroll
            for (int tl = 0; tl < 2; ++tl) {
                f32x4 acc = (f32x4){0.f, 0.f, 0.f, 0.f};
                acc = __builtin_amdgcn_mfma_f32_16x16x32_bf16(kf[i][tl][0], qf0, acc, 0, 0, 0);
                acc = __builtin_amdgcn_mfma_f32_16x16x32_bf16(kf[i][tl][1], qf1, acc, 0, 0, 0);
                sT[i][tl] = acc;
            }
        __builtin_amdgcn_sched_barrier(0);
        f32x4 bs[8][2];
#pragma unroll
        for (int i = 0; i < 8; ++i)
#pragma unroll
            for (int e = 0; e < 4; ++e) { bs[i][0][e] = bbase[i * 64 + e]; bs[i][1][e] = bbase[i * 64 + 4 + e]; }
        float mx = -1e30f;
#pragma unroll
        for (int i = 0; i < 8; ++i)
#pragma unroll
            for (int tl = 0; tl < 2; ++tl)
#pragma unroll
                for (int e = 0; e < 4; ++e) {
                    const int kc = kc0 + 8 * g + tl * 4 + e;
                    const bool valid = (kc >= cs) && (kc < cs + 16);
                    const float v = valid ? sT[i][tl][e] + bs[i][tl][e] : -1e30f;
                    sT[i][tl][e] = v; mx = fmaxf(mx, v);
                }
        __builtin_amdgcn_sched_barrier(0);
        bf16x8 vf[8][4];
#pragma unroll
        for (int i = 0; i < 8; ++i)
#pragma unroll
            for (int dt = 0; dt < 4; ++dt) vf[i][dt] = *(const bf16x8*)(vbase + i * 4096 + dt * 128);
        __builtin_amdgcn_sched_barrier(0);
        mx = fmaxf(mx, __shfl_xor(mx, 16)); mx = fmaxf(mx, __shfl_xor(mx, 32));
        float sum = 0.f;
        bf16x8 pf[8];
#pragma unroll
        for (int i = 0; i < 8; ++i) {
            float e[8];
#pragma unroll
            for (int j = 0; j < 8; ++j) { e[j] = __builtin_amdgcn_exp2f(sT[i][j >> 2][j & 3] - mx); sum += e[j]; }
            const u32x4 pv = (u32x4){cvt_pk_bf16(e[0], e[1]), cvt_pk_bf16(e[2], e[3]), cvt_pk_bf16(e[4], e[5]), cvt_pk_bf16(e[6], e[7])};
            pf[i] = __builtin_bit_cast(bf16x8, pv);
        }
        sum += __shfl_xor(sum, 16); sum += __shfl_xor(sum, 32);
        __builtin_amdgcn_sched_barrier(0);
        f32x4 o[4];
#pragma unroll
        for (int dt = 0; dt < 4; ++dt) o[dt] = (f32x4){0.f, 0.f, 0.f, 0.f};
#pragma unroll
        for (int i = 0; i < 8; ++i)
#pragma unroll
            for (int dt = 0; dt < 4; ++dt) o[dt] = __builtin_amdgcn_mfma_f32_16x16x32_bf16(vf[i][dt], pf[i], o[dt], 0, 0, 0);
        const float inv = 1.0f / sum;
#pragma unroll
        for (int dt = 0; dt < 4; ++dt) {
            u32x2 ov; ov.x = cvt_pk_bf16(o[dt][0] * inv, o[dt][1] * inv); ov.y = cvt_pk_bf16(o[dt][2] * inv, o[dt][3] * inv);
            *(LAS u32x2*)(ost + q16 * 144 + (dt * 16 + 4 * g) * 2) = ov;
        }
        {
            const int qq = lane >> 2, sg = lane & 3;
            const u32x4 r0 = *(const LAS u32x4*)(ost + qq * 144 + sg * 32), r1 = *(const LAS u32x4*)(ost + qq * 144 + sg * 32 + 16);
            bf16_t* op = OQ + ((size_t)b * SEQ + r * 64 + 16 * w + qq) * 3072 + h * 64 + sg * 16;
            *(u32x4*)op = r0; *(u32x4*)(op + 8) = r1;
        }
    }
}

enum PhaseOp { OP_PREP, OP_GU, OP_DN, OP_WIN, OP_ELT0, OP_CONV, OP_TRN, OP_MIXOUT, OP_QKV, OP_QKN, OP_ATTN, OP_WO, OP_NOP };
constexpr int NPHASES = 18 + (PROBE_MASK ? 1 : 0);
__device__ __forceinline__ void phase_info(int ph, int& op, int& f) {
    f = 0;
    switch (ph) {
        case 0: op = OP_PREP; break;
        case 1: op = OP_GU; f = 0; break;  case 2: op = OP_DN; f = 0; break;
        case 3: op = OP_WIN; break;        case 4: op = OP_ELT0; break;      case 5: op = OP_CONV; break;   case 6: op = OP_TRN; break;   case 7: op = OP_MIXOUT; break;
        case 8: op = OP_GU; f = 1; break;  case 9: op = OP_DN; f = 1; break;
        case 10: op = OP_GU; f = 2; break; case 11: op = OP_DN; f = 2; break;
        case 12: op = OP_QKV; break;       case 13: op = OP_QKN; break;      case 14: op = OP_ATTN; break;     case 15: op = OP_WO; break;
        case 16: op = OP_GU; f = 3; break; case 17: op = OP_DN; f = 3; break; default: op = OP_NOP; break;
    }
}

__global__ void __launch_bounds__(NTHREADS, 2) mega_fwd(Args args) {
    extern __shared__ __attribute__((aligned(16))) unsigned char lds_raw[];
    LAS unsigned char* lds = (LAS unsigned char*)lds_raw;
    cg::grid_group grid = cg::this_grid();
    const int G = gridDim.x;
    volatile LAS unsigned* bst = (volatile LAS unsigned*)(lds + (LDS_BYTES - 64));
    if (threadIdx.x < 2) bst[threadIdx.x] = 0u;
    __syncthreads();
    XcdBarrier xbar; xbar.bar = (unsigned*)(args.ws + WS_BAR); xbar.x = 0; xbar.st = bst;
    if (args.ph_hi - args.ph_lo > 1) xbar = xcd_barrier_post((unsigned*)(args.ws + WS_BAR), bst);
    int nseam = 0;
    int ph = args.ph_lo, rep = 0; (void)rep;
    while (ph < args.ph_hi) {
        int tid = threadIdx.x; asm volatile("" : "+v"(tid));
        const int lane = tid & 63, wave = __builtin_amdgcn_readfirstlane(tid >> 6);
        CArgsP ap = (CArgsP)__builtin_amdgcn_kernarg_segment_ptr(); asm volatile("" : "+s"(ap));
        unsigned char* ws = ap->ws;
        unsigned char* outb = (unsigned char*)ap->out;
        float* SS = (float*)(ws + WS_SS);
        bf16_t* XB = (bf16_t*)(ws + WS_XB);
        bf16_t* BIG = (bf16_t*)(ws + WS_BIG);
        bf16_t* MIDp = (bf16_t*)(outb + OUT_MID);
        int op, f; phase_info(ph, op, f);
        if (op == OP_PREP) {
            p0_prologue(ap, lds, tid, lane, wave, G);
        } else if (op == OP_GU) {
            const int ssi = (f == 0) ? 0 : (f == 1) ? 2 : (f == 2) ? 3 : 5;
            pg8::Gemm g{XB, (const bf16_t*)(ws + WS_WGU) + (size_t)f * 5632 * 1024, T, 5632, D, D};
            pg8::StaticOrder S; S.init(T, 5632, G, (int)blockIdx.x);
            pg8::EpiGU E{BIG, FF, SS + (size_t)ssi * T};
            pg8::gemm_phase<pg8::EpiGU, pg8::StaticOrder>(lds, g, S, E, nullptr, tid);
        } else if (op == OP_DN || op == OP_MIXOUT || op == OP_WO) {
            pg8::Gemm g; float alpha; float* ssn; float* outf = nullptr;
            if (op == OP_DN) { g = pg8::Gemm{BIG, (const bf16_t*)(ws + WS_WD) + (size_t)f * 1024 * 2816, T, D, FF, FF}; alpha = 0.5f;
                ssn = (f == 0) ? SS + 1 * (size_t)T : (f == 1) ? SS + 3 * (size_t)T : (f == 2) ? SS + 4 * (size_t)T : nullptr; if (f == 3) outf = (float*)outb; }
            else if (op == OP_MIXOUT) { g = pg8::Gemm{MIDp, (const bf16_t*)(ws + WS_WMO), T, D, D, D}; alpha = 1.0f; ssn = SS + 2 * (size_t)T; }
            else { g = pg8::Gemm{BIG + 1024, (const bf16_t*)(ws + WS_WO), T, D, D, 3072};     alpha = 1.0f; ssn = SS + 5 * (size_t)T; }
            pg8::StaticOrder S; S.init(T, D, G, (int)blockIdx.x);
            pg8::EpiRes E{XB, outf, alpha, ssn};
            pg8::gemm_phase<pg8::EpiRes, pg8::StaticOrder>(lds, g, S, E, nullptr, tid);
        } else if (op == OP_WIN || op == OP_QKV) {
            const int N = (op == OP_WIN) ? 2048 : 3072;
            pg8::Gemm g{XB, (const bf16_t*)(ws + (op == OP_WIN ? WS_WIN : WS_WQKV)), T, N, D, D};
            pg8::StaticOrder S; S.init(T, N, G, (int)blockIdx.x);
            pg8::EpiScale E{BIG, N, SS + (size_t)(op == OP_WIN ? 1 : 4) * T};
            pg8::gemm_phase<pg8::EpiScale, pg8::StaticOrder>(lds, g, S, E, nullptr, tid);
        } else if (op == OP_ELT0) {
            elt0_phase(ap, lds, tid, G);
        } else if (op == OP_CONV) {
            conv_phase(ap, lds, tid, lane, wave, G);
        } else if (op == OP_TRN) {
            trn_phase(ap, lds, tid, G);
        } else if (op == OP_QKN) {
            qkn_phase(ap, lds, tid, G);
        } else if (op == OP_ATTN) {
            attn_phase(ap, lds, tid, lane, wave, G);
        }
#if PROBE_MASK
        if (((ap->rep_mask >> ph) & 1) && rep + 1 < ap->rep_n) ++rep; else { rep = 0; ++ph; }
#else
        ++ph;
#endif
        if (ph < args.ph_hi) {
            if (args.ph_lo < 0) grid.sync();
            xcd_barrier(xbar);
            ++nseam;
        }
    }
}

#ifndef MK_ONE_LAUNCH
#define MK_ONE_LAUNCH 1
#endif
extern "C" void kernel_launch(void* const* d_in, const int* in_sizes, int n_in, void* d_out, int out_size, void* d_ws, size_t ws_size, hipStream_t stream) {
    static int grid = 0;
    if (grid == 0) {
        if (n_in != 27 || out_size != T * D || ws_size < WS_END) { fprintf(stderr, "kernel_launch: unexpected shapes: n_in %d out %d ws %zu\n", n_in, out_size, ws_size); grid = -1; return; }
        int dev = 0, cus = 0, per_cu = 0;
        (void)hipGetDevice(&dev); (void)hipDeviceGetAttribute(&cus, hipDeviceAttributeMultiprocessorCount, dev);
        if (hipFuncSetAttribute((const void*)mega_fwd, hipFuncAttributeMaxDynamicSharedMemorySize, LDS_BYTES) != hipSuccess) { fprintf(stderr, "kernel_launch: hipFuncSetAttribute failed\n"); grid = -1; return; }
        if (hipOccupancyMaxActiveBlocksPerMultiprocessor(&per_cu, (const void*)mega_fwd, NTHREADS, LDS_BYTES) != hipSuccess || per_cu < 1) { fprintf(stderr, "kernel_launch: occupancy query says %d\n", per_cu); per_cu = 1; }
        (void)hipGetLastError();
        grid = cus * per_cu;
        fprintf(stderr, "kernel_launch: grid %d (cus %d x %d)\n", grid, cus, per_cu);
    }
    if (grid < 0) return;
    Args a{};
    for (int i = 0; i < 27; ++i) a.in[i] = (const float*)d_in[i];
    a.out = (float*)d_out; a.ws = (unsigned char*)d_ws; a.rep_mask = PROBE_MASK; a.rep_n = PROBE_N;
#if MK_ONE_LAUNCH
    (void)hipMemsetAsync((unsigned char*)d_ws + WS_BAR, 0, 16384, stream);
    a.ph_lo = 0; a.ph_hi = NPHASES;
    void* kargs[] = {&a};
    hipError_t e = hipLaunchCooperativeKernel((const void*)mega_fwd, dim3(grid), dim3(NTHREADS), kargs, LDS_BYTES, stream);
    if (e != hipSuccess) fprintf(stderr, "kernel_launch: cooperative launch failed: %s (grid %d)\n", hipGetErrorString(e), grid);
#else
    for (int ph = 0; ph < NPHASES; ++ph) {
        a.ph_lo = ph; a.ph_hi = ph + 1;
        hipLaunchKernelGGL(mega_fwd, dim3(grid), dim3(NTHREADS), LDS_BYTES, stream, a);
    }
#endif
}
```
